# Optimizing an MI355X kernel written in HIP

```python
import jax, jax.numpy as jnp
from jax import lax
import numpy as np

D_MODEL = 1024
BATCH = 8
SEQ = 2048
DEPTH = 2

N_GROUPS = 4
GROUP_HEADS = 4
GROUP_WIDTH = D_MODEL // N_GROUPS
HEAD_DIM = GROUP_WIDTH // GROUP_HEADS
MIX_WIDTH = N_GROUPS * GROUP_WIDTH
CONV_WIDTH = 3
RWKV_DECAY_RANK = 64
RWKV_ICLR_RANK = 64
RWKV_GATE_RANK = 128
RWKV_GN_EPS = 64e-5
RET_CHUNK = 128
MLA_Q_RANK = 384
MLA_KV_RANK = 128
MLA_NOPE = 64
MLA_ROPE = 32
MLA_V = 64
ATTN_BLOCK = 128
D_FF = 2816
ROPE_BASE = 10000.0
NORM_EPS = 1e-6
MAX_POS_OFFSET = 4096
IN_SPLITS = (
    GROUP_WIDTH, GROUP_WIDTH, GROUP_WIDTH,
    GROUP_WIDTH, GROUP_WIDTH, GROUP_WIDTH,
    RWKV_DECAY_RANK, RWKV_DECAY_RANK,
    RWKV_ICLR_RANK, RWKV_ICLR_RANK,
    RWKV_GATE_RANK,
    GROUP_WIDTH, GROUP_WIDTH, GROUP_WIDTH, GROUP_WIDTH,
    MLA_Q_RANK, MLA_KV_RANK + MLA_ROPE,
)
IN_WIDTH = sum(IN_SPLITS)

kernel_name = 'hybrid_parallel_mixer_encoder'


def rmsnorm(x, g):
    xf = x.astype(jnp.float32)
    y = xf * lax.rsqrt(jnp.mean(xf * xf, axis=-1, keepdims=True) + NORM_EPS)
    return (y * g.astype(jnp.float32)).astype(x.dtype)


def swiglu(x, w_gate, w_up, w_down):
    return (jax.nn.silu(x @ w_gate) * (x @ w_up)) @ w_down


def rope(x, pos):
    half = x.shape[-1] // 2
    inv = ROPE_BASE ** (-jnp.arange(half, dtype=jnp.float32) / half)
    ang = pos.astype(jnp.float32)[:, :, None, None] * inv
    cos, sin = jnp.cos(ang), jnp.sin(ang)
    xf = x.astype(jnp.float32)
    x1, x2 = xf[..., :half], xf[..., half:]
    return jnp.concatenate([x1 * cos - x2 * sin, x1 * sin + x2 * cos], axis=-1).astype(x.dtype)


def heads(t):
    b, s, _ = t.shape
    return t.reshape(b, s, GROUP_HEADS, HEAD_DIM).astype(jnp.float32)


def short_conv_mixer(x_in, b_gate, c_gate, conv_w):
    u = c_gate * x_in
    y = lax.conv_general_dilated(
        u, conv_w[:, None, :].astype(u.dtype), window_strides=(1,), padding=[(1, 1)],
        dimension_numbers=('NWC', 'WIO', 'NWC'), feature_group_count=GROUP_WIDTH)
    return b_gate * y


def rwkv7_scan(r, k, v, kk, a, decay, reverse):
    xs = tuple(jnp.moveaxis(t, 1, 0) for t in (r, k, v, kk, a, decay))
    b, _, h, n = r.shape

    def step(S, inp):
        r_t, k_t, v_t, kk_t, a_t, w_t = inp
        sa = jnp.einsum('bhvk,bhk->bhv', S, -kk_t)
        S = (S * w_t[:, :, None, :] + sa[..., None] * (kk_t * a_t)[:, :, None, :]
             + v_t[..., None] * k_t[:, :, None, :])
        return S, jnp.einsum('bhvk,bhk->bhv', S, r_t)

    S0 = jnp.zeros((b, h, n, n), jnp.float32)
    _, y = lax.scan(step, S0, xs, reverse=reverse)
    return jnp.moveaxis(y, 0, 1)


def rwkv7_mixer(r, k, v, wd_f, wd_b, ad_f, ad_b, gd, w0_f, w0_b, w2_f, w2_b,
                a0_f, a0_b, a2_f, a2_b, g2, k_k, k_a, r_k, lnx_g, lnx_b):
    b, s, _ = r.shape
    g = jax.nn.sigmoid(gd) @ g2
    kk = heads(k * k_k)
    kk = kk / jnp.maximum(jnp.sqrt(jnp.sum(kk * kk, axis=-1, keepdims=True)), 1e-12)
    rh, vh = heads(r), heads(v)
    y = jnp.zeros_like(rh)
    k_sum = jnp.zeros_like(rh)
    for wd, ad, w0, w2, a0, a2, rev in ((wd_f, ad_f, w0_f, w2_f, a0_f, a2_f, False),
                                        (wd_b, ad_b, w0_b, w2_b, a0_b, a2_b, True)):
        w_log = -jax.nn.softplus(-(w0 + jnp.tanh(wd) @ w2)) - 0.5
        decay = jnp.exp(-jnp.exp(w_log.astype(jnp.float32)))
        a = jax.nn.sigmoid(a0 + ad @ a2)
        k_dir = heads(k * (1.0 + (a - 1.0) * k_a))
        y = y + rwkv7_scan(rh, k_dir, vh, kk, heads(a), heads(decay), rev)
        k_sum = k_sum + k_dir
    mu = jnp.mean(y, axis=-1, keepdims=True)
    var = jnp.mean(jnp.square(y - mu), axis=-1, keepdims=True)
    yn = ((y - mu) * lax.rsqrt(var + RWKV_GN_EPS)).reshape(b, s, GROUP_WIDTH)
    yn = yn * lnx_g.astype(jnp.float32) + lnx_b.astype(jnp.float32)
    bonus = (jnp.sum(rh * k_sum * r_k.astype(jnp.float32), axis=-1, keepdims=True) * vh).reshape(b, s, GROUP_WIDTH)
    return (yn + bonus).astype(r.dtype) * g


def retention_mixer(q, k, v, g, pos, gn_g):
    b, s, _ = q.shape
    nc, C = s // RET_CHUNK, RET_CHUNK
    qh = rope(q.reshape(b, s, GROUP_HEADS, HEAD_DIM), pos)
    kh = rope(k.reshape(b, s, GROUP_HEADS, HEAD_DIM), pos) * (HEAD_DIM ** -0.5)
    vh = v.reshape(b, s, GROUP_HEADS, HEAD_DIM)
    chunk = lambda t: t.reshape(b, nc, C, GROUP_HEADS, HEAD_DIM).transpose(0, 3, 1, 2, 4).astype(jnp.float32)
    qc, kc, vc = chunk(qh), chunk(kh), chunk(vh)
    log_gamma = jnp.log(1.0 - 2.0 ** (-5.0 - jnp.arange(GROUP_HEADS, dtype=jnp.float32)))
    idx = jnp.arange(C, dtype=jnp.float32)
    intra_decay = jnp.exp(log_gamma[:, None, None] * jnp.abs(idx[:, None] - idx[None, :]))
    dec_start = jnp.exp(log_gamma[:, None] * idx)[None, :, None, :, None]
    dec_end = jnp.exp(log_gamma[:, None] * (C - idx))[None, :, None, :, None]
    chunk_decay = jnp.exp(log_gamma * C)[None, :, None, None]
    scores = jnp.einsum('bhnid,bhnjd->bhnij', qc, kc) * intra_decay[None, :, None]
    o = jnp.einsum('bhnij,bhnjd->bhnid', scores, vc)
    kv_f = jnp.einsum('bhnjd,bhnje->nbhde', kc * dec_end, vc)
    kv_b = jnp.einsum('bhnjd,bhnje->nbhde', kc * dec_start, vc)

    def step(R, summ):
        return R * chunk_decay + summ, R

    R0 = jnp.zeros((b, GROUP_HEADS, HEAD_DIM, HEAD_DIM), jnp.float32)
    _, R_f = lax.scan(step, R0, kv_f)
    _, R_b = lax.scan(step, R0, kv_b, reverse=True)
    o = (o + dec_start * jnp.einsum('bhnid,nbhde->bhnie', qc, R_f)
         + dec_end * jnp.einsum('bhnid,nbhde->bhnie', qc, R_b))
    o = o.transpose(0, 2, 3, 1, 4).reshape(b, s, GROUP_HEADS, HEAD_DIM)
    o = o * lax.rsqrt(jnp.mean(o * o, axis=-1, keepdims=True) + NORM_EPS)
    o = o.reshape(b, s, GROUP_WIDTH) * gn_g.astype(jnp.float32)
    return jax.nn.silu(g) * o.astype(q.dtype)


def mla_mixer(q_a, kv_a, pos, q_a_norm, q_b, kv_a_norm, kv_b):
    b, s, _ = q_a.shape
    q = (rmsnorm(q_a, q_a_norm) @ q_b).reshape(b, s, GROUP_HEADS, MLA_NOPE + MLA_ROPE)
    q_nope, q_rope = q[..., :MLA_NOPE], rope(q[..., MLA_NOPE:], pos)
    c_kv, k_rope = kv_a[..., :MLA_KV_RANK], kv_a[..., MLA_KV_RANK:]
    kv = (rmsnorm(c_kv, kv_a_norm) @ kv_b).reshape(b, s, GROUP_HEADS, MLA_NOPE + MLA_V)
    k_nope, v = kv[..., :MLA_NOPE], kv[..., MLA_NOPE:]
    k_rope = rope(k_rope[:, :, None, :], pos)[:, :, 0]
    scale = (MLA_NOPE + MLA_ROPE) ** -0.5
    nb = s // ATTN_BLOCK
    blocks = lambda t: t.reshape(b, nb, ATTN_BLOCK, GROUP_HEADS, t.shape[-1]).transpose(1, 0, 2, 3, 4)

    def attend(blk):
        qn, qr = blk
        sc = jnp.einsum('bqhd,bkhd->bhqk', qn, k_nope) + jnp.einsum('bqhr,bkr->bhqk', qr, k_rope)
        p = jax.nn.softmax(sc.astype(jnp.float32) * scale, axis=-1)
        return jnp.einsum('bhqk,bkhd->bqhd', p.astype(v.dtype), v)

    o = lax.map(attend, (blocks(q_nope), blocks(q_rope)))
    return o.transpose(1, 0, 2, 3, 4).reshape(b, s, GROUP_WIDTH)


def setup_inputs(seed: int = 0) -> dict:
    key = jax.random.key(seed)
    ks = iter(jax.random.split(key, 48))
    L, W, H, N = DEPTH, GROUP_WIDTH, GROUP_HEADS, HEAD_DIM
    f32 = jnp.float32

    def nrm(shape):
        return jax.random.normal(next(ks), shape, f32)

    def dense(shape, fan_in, scale=1.0):
        return nrm(shape) * (scale * fan_in ** -0.5)

    def gain(shape):
        return 1.0 + 0.02 * nrm(shape)

    decay_base = jnp.tile(jnp.linspace(-6.0, -1.0, N, dtype=f32), H)
    x = nrm((BATCH, SEQ, D_MODEL))
    offsets = jax.random.randint(next(ks), (BATCH, 1), 0, MAX_POS_OFFSET, dtype=jnp.int32)
    positions = offsets + jnp.arange(SEQ, dtype=jnp.int32)[None, :]
    return {
        'x': x,
        'positions': positions,
        'ffn1_norm': gain((L, D_MODEL)),
        'ffn1_w_gate': dense((L, D_MODEL, D_FF), D_MODEL),
        'ffn1_w_up': dense((L, D_MODEL, D_FF), D_MODEL),
        'ffn1_w_down': dense((L, D_FF, D_MODEL), D_FF),
        'mix_norm': gain((L, D_MODEL)),
        'w_in': dense((L, D_MODEL, IN_WIDTH), D_MODEL),
        'w_out': dense((L, MIX_WIDTH, D_MODEL), MIX_WIDTH),
        'conv_w': dense((L, CONV_WIDTH, W), CONV_WIDTH),
        'rwkv_w0_f': decay_base + 0.1 * nrm((L, W)),
        'rwkv_w0_b': decay_base + 0.1 * nrm((L, W)),
        'rwkv_w2_f': dense((L, RWKV_DECAY_RANK, W), RWKV_DECAY_RANK, 0.1),
        'rwkv_w2_b': dense((L, RWKV_DECAY_RANK, W), RWKV_DECAY_RANK, 0.1),
        'rwkv_a0_f': 0.1 * nrm((L, W)),
        'rwkv_a0_b': 0.1 * nrm((L, W)),
        'rwkv_a2_f': dense((L, RWKV_ICLR_RANK, W), RWKV_ICLR_RANK, 0.1),
        'rwkv_a2_b': dense((L, RWKV_ICLR_RANK, W), RWKV_ICLR_RANK, 0.1),
        'rwkv_g2': dense((L, RWKV_GATE_RANK, W), RWKV_GATE_RANK),
        'rwkv_k_k': 0.85 + 0.02 * nrm((L, W)),
        'rwkv_k_a': 1.0 + 0.02 * nrm((L, W)),
        'rwkv_r_k': 0.1 * nrm((L, H, N)),
        'rwkv_lnx_g': gain((L, W)),
        'rwkv_lnx_b': 0.01 * nrm((L, W)),
        'ret_gn_g': gain((L, W)),
        'mla_q_a_norm': gain((L, MLA_Q_RANK)),
        'mla_q_b': dense((L, MLA_Q_RANK, H * (MLA_NOPE + MLA_ROPE)), MLA_Q_RANK),
        'mla_kv_a_norm': gain((L, MLA_KV_RANK)),
        'mla_kv_b': dense((L, MLA_KV_RANK, H * (MLA_NOPE + MLA_V)), MLA_KV_RANK),
        'ffn2_norm': gain((L, D_MODEL)),
        'ffn2_w_gate': dense((L, D_MODEL, D_FF), D_MODEL),
        'ffn2_w_up': dense((L, D_MODEL, D_FF), D_MODEL),
        'ffn2_w_down': dense((L, D_FF, D_MODEL), D_FF),
        'final_norm': gain((D_MODEL,)),
    }


def reference(x, positions, ffn1_norm, ffn1_w_gate, ffn1_w_up, ffn1_w_down, mix_norm, w_in, w_out,
              conv_w, rwkv_w0_f, rwkv_w0_b, rwkv_w2_f, rwkv_w2_b, rwkv_a0_f, rwkv_a0_b, rwkv_a2_f,
              rwkv_a2_b, rwkv_g2, rwkv_k_k, rwkv_k_a, rwkv_r_k, rwkv_lnx_g, rwkv_lnx_b, ret_gn_g,
              mla_q_a_norm, mla_q_b, mla_kv_a_norm, mla_kv_b, ffn2_norm, ffn2_w_gate, ffn2_w_up,
              ffn2_w_down, final_norm):
    split_points = tuple(int(p) for p in np.cumsum(IN_SPLITS)[:-1])
    for l in range(DEPTH):
        x = x + 0.5 * swiglu(rmsnorm(x, ffn1_norm[l]), ffn1_w_gate[l], ffn1_w_up[l], ffn1_w_down[l])
        h = rmsnorm(x, mix_norm[l])
        u = h @ w_in[l]
        (c_x, c_b, c_c, rw_r, rw_k, rw_v, rw_wd_f, rw_wd_b, rw_ad_f, rw_ad_b, rw_gd,
         rt_q, rt_k, rt_v, rt_g, ml_qa, ml_kva) = jnp.split(u, split_points, axis=-1)
        y_conv = short_conv_mixer(c_x, c_b, c_c, conv_w[l])
        y_rwkv = rwkv7_mixer(rw_r, rw_k, rw_v, rw_wd_f, rw_wd_b, rw_ad_f, rw_ad_b, rw_gd,
                             rwkv_w0_f[l], rwkv_w0_b[l], rwkv_w2_f[l], rwkv_w2_b[l],
                             rwkv_a0_f[l], rwkv_a0_b[l], rwkv_a2_f[l], rwkv_a2_b[l], rwkv_g2[l],
                             rwkv_k_k[l], rwkv_k_a[l], rwkv_r_k[l], rwkv_lnx_g[l], rwkv_lnx_b[l])
        y_ret = retention_mixer(rt_q, rt_k, rt_v, rt_g, positions, ret_gn_g[l])
        y_mla = mla_mixer(ml_qa, ml_kva, positions, mla_q_a_norm[l], mla_q_b[l], mla_kv_a_norm[l], mla_kv_b[l])
        x = x + jnp.concatenate([y_conv, y_rwkv, y_ret, y_mla], axis=-1) @ w_out[l]
        x = x + 0.5 * swiglu(rmsnorm(x, ffn2_norm[l]), ffn2_w_gate[l], ffn2_w_up[l], ffn2_w_down[l])
    return rmsnorm(x, final_norm)
```

```cpp
#include <hip/hip_runtime.h>
#include <hip/hip_cooperative_groups.h>
#include <cstdint>
#include <cstdio>
namespace cg = cooperative_groups;

#define LAS __attribute__((address_space(3)))
typedef unsigned short bf16_t;
typedef short bf16x8 __attribute__((ext_vector_type(8)));
typedef short s16x4 __attribute__((ext_vector_type(4)));
typedef float f32x4 __attribute__((ext_vector_type(4)));
typedef float f32x16 __attribute__((ext_vector_type(16)));
typedef float f32x2 __attribute__((ext_vector_type(2)));
typedef unsigned u32x4 __attribute__((ext_vector_type(4)));
typedef unsigned u32x2 __attribute__((ext_vector_type(2)));

constexpr int MTOK = 16384, SEQ = 2048, DM = 1024, FF = 2816, NU = 3584, INW = 3488;
constexpr float NEPS = 1e-6f;
constexpr int U_CX = 0, U_CB = 256, U_CC = 512, U_RK = 768, U_RR = 1024, U_RV = 1280, U_TQ = 1536, U_TG = 1792, U_TK = 2048,
              U_TV = 2304, U_QA = 2560, U_CKV = 2944, U_LORA = 3072, U_KR = 3456;
constexpr size_t MiB = 1u << 20;
constexpr size_t WS_SSQ = 0;
constexpr size_t WS_WGU1 = 1 * MiB, WS_WD1 = 12 * MiB, WS_WIN = 17 * MiB + 512 * 1024, WS_WLORA = 24 * MiB + 512 * 1024, WS_WMLA = 25 * MiB + 512 * 1024;
constexpr size_t WS_WOUT = 27 * MiB, WS_WGU2 = 29 * MiB, WS_WD2 = 40 * MiB;
constexpr size_t WS_XB = 46 * MiB;
constexpr size_t WS_YF = 46 * MiB, WS_YB = 54 * MiB, WS_AB = 62 * MiB, WS_GG = 70 * MiB;
constexpr size_t WS_U = 78 * MiB;
constexpr size_t WS_EF = 190 * MiB, WS_EB = 198 * MiB, WS_AF = 206 * MiB;
constexpr size_t WS_QM = 214 * MiB, WS_KN = 226 * MiB, WS_KR = 234 * MiB, WS_VTM = 235 * MiB, WS_VTR = 243 * MiB, WS_END = 255 * MiB;
constexpr size_t WS_SSQP = 251 * MiB, WS_SQQ = 253 * MiB, WS_SQKV = 254 * MiB;
constexpr int LDS_BYTES = 147456;

struct Args { const float* in[34]; float* out; unsigned char* ws; int ph_lo, ph_hi; };

__device__ __forceinline__ unsigned f2bf(float f) { unsigned u = __float_as_uint(f); return (u + 0x7fffu + ((u >> 16) & 1u)) >> 16; }
typedef __bf16 hwbf16x2 __attribute__((ext_vector_type(2)));
__device__ __forceinline__ unsigned pk2(float lo, float hi) { const f32x2 v = {lo, hi}; return __builtin_bit_cast(unsigned, __builtin_convertvector(v, hwbf16x2)); }
__device__ __forceinline__ float bflo(unsigned w) { return __uint_as_float(w << 16); }
__device__ __forceinline__ float bfhi(unsigned w) { return __uint_as_float(w & 0xffff0000u); }
__device__ __forceinline__ u32x4 pk8(const float* v) { u32x4 w; w.x = pk2(v[0], v[1]); w.y = pk2(v[2], v[3]); w.z = pk2(v[4], v[5]); w.w = pk2(v[6], v[7]); return w; }
__device__ __forceinline__ void unpk8(u32x4 w, float* v) { v[0] = bflo(w.x); v[1] = bfhi(w.x); v[2] = bflo(w.y); v[3] = bfhi(w.y); v[4] = bflo(w.z); v[5] = bfhi(w.z); v[6] = bflo(w.w); v[7] = bfhi(w.w); }
__device__ __forceinline__ float sigmoidf_(float x) { return __builtin_amdgcn_rcpf(1.0f + __expf(-x)); }
template <int CTRL> __device__ __forceinline__ float dppf(float x) { return __int_as_float(__builtin_amdgcn_update_dpp(0, __float_as_int(x), CTRL, 0xF, 0xF, true)); }
__device__ __forceinline__ float rowsum16(float x) { x += dppf<0xB1>(x); x += dppf<0x4E>(x); x += dppf<0x124>(x); x += dppf<0x128>(x); return x; }
__device__ __forceinline__ float wavesum(float v) { for (int o = 32; o > 0; o >>= 1) v += __shfl_xor(v, o); return v; }
__device__ __forceinline__ float sum16(const float* p) { const f32x4 a = *(const f32x4*)p, b = *(const f32x4*)(p + 4), c = *(const f32x4*)(p + 8), d = *(const f32x4*)(p + 12);
    return (((a[0] + a[1]) + (a[2] + a[3])) + ((b[0] + b[1]) + (b[2] + b[3]))) + (((c[0] + c[1]) + (c[2] + c[3])) + ((d[0] + d[1]) + (d[2] + d[3]))); }
__device__ __forceinline__ float sum12(const float* p) { const f32x4 a = *(const f32x4*)p, b = *(const f32x4*)(p + 4), c = *(const f32x4*)(p + 8);
    return (((a[0] + a[1]) + (a[2] + a[3])) + ((b[0] + b[1]) + (b[2] + b[3]))) + ((c[0] + c[1]) + (c[2] + c[3])); }
__device__ __forceinline__ float sum4(const float* p) { const f32x4 a = *(const f32x4*)p; return (a[0] + a[1]) + (a[2] + a[3]); }
__device__ __forceinline__ void rope_cs(int p, float inv, float& c, float& s) {
    const float ang = (float)p * inv; const float rev = ang * 0.15915494309189535f; const float fr = rev - floorf(rev);
    c = __builtin_amdgcn_cosf(fr); s = __builtin_amdgcn_sinf(fr);
}

namespace pg8 {
constexpr int BM = 256, BK = 64, HALF = 128, HTB = HALF * BK * 2, NXCD = 8, WGM = 8;
__host__ __device__ __forceinline__ int lds_byte(int r, int c) { const int st = (r >> 4) * 2 + (c >> 5), rr = r & 15, cc = c & 31, ob = rr * 64 + cc * 2; return st * 1024 + (ob ^ (((ob >> 9) & 1) << 5)); }
__host__ __device__ __forceinline__ void stage_rc(int b, int& R, int& C) { const int st = b / 1024, sb = b % 1024, swz = sb ^ (((sb >> 9) & 1) << 5); R = (st >> 1) * 16 + swz / 64; C = (st & 1) * 32 + (swz % 64) / 2; }
__host__ __device__ __forceinline__ int perm32(int rho) { const int n = rho >> 4, i = rho & 15; return 8 * (i >> 2) + 4 * n + (i & 3); }
struct Unit { int pm, pn; };
struct Gemm { const bf16_t* A; const bf16_t* Bt; int M, N, K, lda, kseg; };
struct StaticOrder {
    int nM, nN, nwg, G, c;
    __device__ void init(int M, int N, int G_, int c_) { nM = M / BM; nN = N / BM; nwg = nM * nN; G = G_; c = c_; }
    __device__ bool next(int i, Unit& u) const {
        const long L = (long)i * G + c; if (L >= nwg) return false;
        int wgid = (int)L; { const int q = nwg / NXCD, r = nwg % NXCD, xcd = wgid % NXCD, off = wgid / NXCD; wgid = (xcd < r ? xcd * (q + 1) : r * (q + 1) + (xcd - r) * q) + off; }
        const int nig = WGM * nN, gid = wgid / nig, fm = gid * WGM, gsz = (nM - fm) < WGM ? (nM - fm) : WGM;
        u.pm = fm + ((wgid % nig) % gsz); u.pn = (wgid % nig) / gsz; return true;
    }
};
template <class Epi, class Sched>
__device__ __forceinline__ void gemm_phase(LAS unsigned char* lds, const Gemm g, const Sched& S, const Epi& E, const int tid) {
    const int wid = __builtin_amdgcn_readfirstlane(tid >> 6), lane = tid & 63, wr = wid >> 2, wc = wid & 3, fr = lane & 15, fq = lane >> 4;
    const int K = g.K, nt = K / BK;
    unsigned voffA[2], voffB[2];
#pragma unroll
    for (int i = 0; i < 2; ++i) { int R, C; stage_rc(tid * 16 + i * 8192, R, C); const int Rb = (R & ~31) + perm32(R & 31);
        voffA[i] = (unsigned)(R * g.lda + C) * 2u; voffB[i] = (unsigned)(Rb * K + C) * 2u; }
    const size_t kstep = (size_t)(BK * 2);
    const size_t hstepA = (size_t)HALF * g.lda * 2, tstepA = 2 * hstepA;
    const size_t hstepB = (size_t)HALF * K * 2, tstepB = 2 * hstepB;
    const size_t kseg = (size_t)g.kseg;
    const unsigned ldsw = (unsigned)wid * 1024u;
    const int aoff = lds_byte(wr * 64 + fr, fq * 8), boff = lds_byte(wc * 32 + fr, fq * 8);
#define KOFFA(t) ((size_t)((t) >> 2) * kseg + (size_t)((t) & 3) * kstep)
#define PG8_SA(b, h) (((b) * 2 + (h)) * HTB)
#define PG8_SB(b, h) ((4 + (b) * 2 + (h)) * HTB)
#define PG8_STAGE(bufoff, gbase, voff) do { _Pragma("unroll") for (int _i = 0; _i < 2; ++_i) { unsigned _vo = (voff)[_i]; asm volatile("" : "+v"(_vo)); \
        __builtin_amdgcn_global_load_lds((const unsigned*)((const char*)(gbase) + _vo), (LAS unsigned*)(lds + (bufoff) + ldsw + _i * 8192), 16, 0, 0); } } while (0)
#define PG8_LDA(dst, b, h) do { _Pragma("unroll") for (int m = 0; m < 4; ++m) _Pragma("unroll") for (int k = 0; k < 2; ++k) dst[m][k] = *(const LAS bf16x8*)(lds + PG8_SA(b, h) + aoff + m * 2048 + k * 1024); } while (0)
#define PG8_LDB(dst, b, h) do { _Pragma("unroll") for (int n = 0; n < 2; ++n) _Pragma("unroll") for (int k = 0; k < 2; ++k) dst[n][k] = *(const LAS bf16x8*)(lds + PG8_SB(b, h) + boff + n * 2048 + k * 1024); } while (0)
#define PG8_MMA(ai, bj, At, Bt) do { __builtin_amdgcn_s_setprio(1); _Pragma("unroll") for (int m = 0; m < 4; ++m) _Pragma("unroll") for (int n = 0; n < 2; ++n) _Pragma("unroll") for (int k = 0; k < 2; ++k) \
        acc[ai][bj][m][n] = __builtin_amdgcn_mfma_f32_16x16x32_bf16(Bt[n][k], At[m][k], acc[ai][bj][m][n], 0, 0, 0); __builtin_amdgcn_s_setprio(0); } while (0)
#define PG8_WAIT_V(n) asm volatile("s_waitcnt vmcnt(" #n ")" ::: "memory")
#define PG8_WAIT_L(n) asm volatile("s_waitcnt lgkmcnt(" #n ")" ::: "memory")
#define PG8_BAR __builtin_amdgcn_s_barrier()
#define PG8_SCHED __builtin_amdgcn_sched_barrier(0)
    Unit cur, nxt; int ui = 0;
    if (!S.next(0, cur)) return;
    f32x4 acc[2][2][4][2];
#pragma unroll
    for (int a = 0; a < 2; ++a)
#pragma unroll
        for (int b = 0; b < 2; ++b)
#pragma unroll
            for (int m = 0; m < 4; ++m)
#pragma unroll
                for (int n = 0; n < 2; ++n) acc[a][b][m][n] = (f32x4){0.f, 0.f, 0.f, 0.f};
    bf16x8 At[4][2], B0[2][2], B1[2][2];
    const char* cA = (const char*)g.A + (size_t)cur.pm * tstepA; const char* cB = (const char*)g.Bt + (size_t)cur.pn * tstepB;
    PG8_STAGE(PG8_SB(0, 0), cB, voffB); PG8_STAGE(PG8_SB(0, 1), cB + hstepB, voffB); PG8_STAGE(PG8_SA(0, 0), cA, voffA); PG8_STAGE(PG8_SA(0, 1), cA + hstepA, voffA);
    if (wr == 1) PG8_BAR;
    PG8_WAIT_V(2); PG8_BAR;
    PG8_STAGE(PG8_SB(1, 0), cB + kstep, voffB); PG8_STAGE(PG8_SA(1, 0), cA + KOFFA(1), voffA); PG8_STAGE(PG8_SB(1, 1), cB + hstepB + kstep, voffB);
    PG8_WAIT_V(6); PG8_BAR;
    for (;;) {
        const bool has_next = S.next(ui + 1, nxt);
        const char* nA = has_next ? (const char*)g.A + (size_t)nxt.pm * tstepA : cA; const char* nB = has_next ? (const char*)g.Bt + (size_t)nxt.pn * tstepB : cB;
#pragma unroll 1
        for (int t = 0; t < nt; t += 2) {
            const bool last = (t == nt - 2);
            const char* a1 = cA + KOFFA(t + 1);
            const char* a2 = last ? nA : cA + KOFFA(t + 2); const char* b2 = last ? nB : cB + (size_t)(t + 2) * kstep;
            const char* a3 = last ? nA + KOFFA(1) : cA + KOFFA(t + 3); const char* b3 = b2 + kstep;
            PG8_LDB(B0, 0, 0); PG8_LDB(B1, 0, 1); PG8_SCHED; PG8_LDA(At, 0, 0); PG8_STAGE(PG8_SA(1, 1), a1 + hstepA, voffA);
            PG8_WAIT_V(8); PG8_WAIT_L(0); PG8_BAR; PG8_MMA(0, 0, At, B0); PG8_MMA(0, 1, At, B1); PG8_BAR; PG8_SCHED;
            PG8_LDA(At, 0, 1); PG8_STAGE(PG8_SB(0, 0), b2, voffB); PG8_STAGE(PG8_SB(0, 1), b2 + hstepB, voffB); PG8_STAGE(PG8_SA(0, 0), a2, voffA);
            PG8_WAIT_V(8); PG8_WAIT_L(0); PG8_BAR; PG8_MMA(1, 0, At, B0); PG8_MMA(1, 1, At, B1); PG8_BAR; PG8_SCHED;
            PG8_LDB(B0, 1, 0); PG8_LDB(B1, 1, 1); PG8_SCHED; PG8_LDA(At, 1, 0); PG8_STAGE(PG8_SA(0, 1), a2 + hstepA, voffA);
            PG8_WAIT_V(8); PG8_WAIT_L(0); PG8_BAR; PG8_MMA(0, 0, At, B0); PG8_MMA(0, 1, At, B1); PG8_BAR; PG8_SCHED;
            PG8_LDA(At, 1, 1); PG8_STAGE(PG8_SB(1, 0), b3, voffB); PG8_STAGE(PG8_SB(1, 1), b3 + hstepB, voffB); PG8_STAGE(PG8_SA(1, 0), a3, voffA);
            PG8_WAIT_V(8); PG8_WAIT_L(0); PG8_BAR; PG8_MMA(1, 0, At, B0); PG8_MMA(1, 1, At, B1); PG8_BAR; PG8_SCHED;
        }
        if (wr == 0) PG8_BAR;
        E(acc, cur, wr, wc, fr, fq);
        if (!has_next) break;
#pragma unroll
        for (int a = 0; a < 2; ++a)
#pragma unroll
            for (int b = 0; b < 2; ++b)
#pragma unroll
                for (int m = 0; m < 4; ++m)
#pragma unroll
                    for (int n = 0; n < 2; ++n) acc[a][b][m][n] = (f32x4){0.f, 0.f, 0.f, 0.f};
        cur = nxt; cA = nA; cB = nB; ++ui;
        if (wr == 1) PG8_BAR;
    }
    PG8_WAIT_V(0);
    PG8_BAR;
#undef KOFFA
#undef PG8_SA
#undef PG8_SB
#undef PG8_STAGE
#undef PG8_LDA
#undef PG8_LDB
#undef PG8_MMA
#undef PG8_WAIT_V
#undef PG8_WAIT_L
#undef PG8_BAR
#undef PG8_SCHED
}
typedef f32x4 Acc[2][2][4][2];

struct EpiGU {
    const float* ssq; bf16_t* H;
    __device__ __forceinline__ void operator()(const Acc& acc, const Unit& u, int wr, int wc, int fr, int fq) const {
#pragma unroll
        for (int ai = 0; ai < 2; ++ai)
#pragma unroll
            for (int m = 0; m < 4; ++m) {
                const int row = u.pm * BM + ai * HALF + wr * 64 + m * 16 + fr;
                const float rs = rsqrtf(sum16(ssq + (size_t)row * 16) * (1.0f / DM) + NEPS);
                float hv[8];
#pragma unroll
                for (int n = 0; n < 2; ++n)
#pragma unroll
                    for (int j = 0; j < 4; ++j) { const float gv = acc[ai][0][m][n][j] * rs, uv = acc[ai][1][m][n][j] * rs; hv[4 * n + j] = gv * sigmoidf_(gv) * uv; }
                *(u32x4*)(H + (size_t)row * FF + u.pn * HALF + wc * 32 + fq * 8) = pk8(hv);
            }
    }
};
struct EpiRes {
    const float* xin; float* xout; bf16_t* xb; float* ssq_next; float alpha; int dry;
    __device__ __forceinline__ void operator()(const Acc& acc, const Unit& u, int wr, int wc, int fr, int fq) const {
#pragma unroll
        for (int ai = 0; ai < 2; ++ai)
#pragma unroll
            for (int m = 0; m < 4; ++m) {
                const int row = u.pm * BM + ai * HALF + wr * 64 + m * 16 + fr;
                float sq = 0.f;
#pragma unroll
                for (int bj = 0; bj < 2; ++bj) {
                    const size_t off = (size_t)row * DM + u.pn * BM + bj * HALF + wc * 32 + fq * 8;
                    f32x4 x0 = *(const f32x4*)(xin + off), x1 = *(const f32x4*)(xin + off + 4);
                    x0 += alpha * acc[ai][bj][m][0]; x1 += alpha * acc[ai][bj][m][1];
                    if (dry <= 0) { *(f32x4*)(xout + off) = x0; *(f32x4*)(xout + off + 4) = x1; }
                    float v[8] = {x0[0], x0[1], x0[2], x0[3], x1[0], x1[1], x1[2], x1[3]};
                    if (dry >= 0) *(u32x4*)(xb + off) = pk8(v);
#pragma unroll
                    for (int j = 0; j < 8; ++j) sq += v[j] * v[j];
                }
                sq += __shfl_xor(sq, 16); sq += __shfl_xor(sq, 32);
                if (fq == 0) ssq_next[(size_t)row * 16 + u.pn * 4 + wc] = sq;
            }
    }
};
struct EpiWin {
    const float* ssq; const int* pos; bf16_t* U; float* ssq_q; float* ssq_kv; bf16_t* KR; bf16_t* VTR;
    __device__ __forceinline__ void operator()(const Acc& acc, const Unit& u, int wr, int wc, int fr, int fq) const {
#pragma unroll
        for (int bj = 0; bj < 2; ++bj) {
            const int hf = 2 * u.pn + bj;
            int mode = 0;
            if (hf == 12 || hf == 13 || hf == 16 || hf == 17) mode = 1; else if (hf == 18 || hf == 19) mode = 2; else if (hf >= 20 && hf <= 22) mode = 3;
            else if (hf == 23) mode = 4; else if (hf == 24) mode = 5; else if (hf == 26) mode = 6; else if (hf == 27) mode = 7;
            float inv[4];
#pragma unroll
            for (int q = 0; q < 4; ++q) { const int n = q >> 1, pp = q & 1;
                inv[q] = (mode == 7) ? exp2f(-(float)(4 * fq + 2 * n + pp) * (13.287712379549449f / 16.0f)) : exp2f(-(float)(16 * (wc & 1) + 4 * fq + 2 * n + pp) * (13.287712379549449f / 32.0f)); }
#pragma unroll
            for (int ai = 0; ai < 2; ++ai)
#pragma unroll
                for (int m = 0; m < 4; ++m) {
                    const int row = u.pm * BM + ai * HALF + wr * 64 + m * 16 + fr;
                    const float rs = rsqrtf(sum16(ssq + (size_t)row * 16) * (1.0f / DM) + NEPS);
                    float v[8];
#pragma unroll
                    for (int n = 0; n < 2; ++n)
#pragma unroll
                        for (int j = 0; j < 4; ++j) v[4 * n + j] = acc[ai][bj][m][n][j] * rs;
                    if (mode == 1 || mode == 7) {
                        const int p = pos[row];
#pragma unroll
                        for (int q = 0; q < 4; ++q) { float c, s; rope_cs(p, inv[q], c, s); const float x1 = v[2 * q], x2 = v[2 * q + 1]; v[2 * q] = x1 * c - x2 * s; v[2 * q + 1] = x1 * s + x2 * c; }
                    } else if (mode == 5) {
#pragma unroll
                        for (int j = 0; j < 8; ++j) { const float e = __expf(2.0f * v[j]); v[j] = 1.0f - 2.0f * __builtin_amdgcn_rcpf(e + 1.0f); }
                    } else if (mode == 6) {
#pragma unroll
                        for (int j = 0; j < 8; ++j) v[j] = sigmoidf_(v[j]);
                    }
                    if (mode == 2) {
                        const int b = row >> 11, t = row & 2047, h = 2 * (hf - 18) + (wc >> 1), dv0 = 32 * (wc & 1) + 8 * fq;
                        bf16_t* vt = VTR + ((size_t)((b * 4 + h) * 64 + dv0)) * SEQ + t;
#pragma unroll
                        for (int j = 0; j < 8; ++j) vt[(size_t)j * SEQ] = (bf16_t)f2bf(v[j]);
                    } else if (mode == 7) {
                        if (wc == 0) *(u32x4*)(KR + (size_t)row * 32 + fq * 8) = pk8(v);
                    } else {
                        *(u32x4*)(U + (size_t)row * NU + hf * HALF + wc * 32 + fq * 8) = pk8(v);
                        if (mode == 3 || mode == 4) {
                            float sq = 0.f;
#pragma unroll
                            for (int j = 0; j < 8; ++j) sq += v[j] * v[j];
                            sq += __shfl_xor(sq, 16); sq += __shfl_xor(sq, 32);
                            if (fq == 0) { if (mode == 3) ssq_q[(size_t)row * 16 + (hf - 20) * 4 + wc] = sq; else ssq_kv[(size_t)row * 4 + wc] = sq; }
                        }
                    }
                    __builtin_amdgcn_sched_barrier(0);
                }
        }
    }
};
struct EpiLora {
    unsigned char* ws; const float* b0; const float* b1; const float* b2; const float* b3;
    __device__ __forceinline__ void operator()(const Acc& acc, const Unit& u, int wr, int wc, int fr, int fq) const {
        const int comp = u.pn;
        bf16_t* D = (bf16_t*)(ws + (comp < 3 ? WS_EF + (size_t)comp * 8 * MiB : WS_AB + (size_t)(comp - 3) * 8 * MiB));
        const float* B = comp == 0 ? b0 : comp == 1 ? b1 : comp == 2 ? b2 : b3;
        const float c0 = comp < 2 ? 0.6065306597126334f : 1.0f;
        const bool act = comp < 4;
#pragma unroll
        for (int bj = 0; bj < 2; ++bj) {
            const int ch = bj * HALF + wc * 32 + fq * 8;
            f32x4 bb0 = {0.f, 0.f, 0.f, 0.f}, bb1 = {0.f, 0.f, 0.f, 0.f};
            if (act) { bb0 = *(const f32x4*)(B + ch); bb1 = *(const f32x4*)(B + ch + 4); }
#pragma unroll
            for (int ai = 0; ai < 2; ++ai)
#pragma unroll
                for (int m = 0; m < 4; ++m) {
                    const int row = u.pm * BM + ai * HALF + wr * 64 + m * 16 + fr;
                    const f32x4 x0 = acc[ai][bj][m][0] + bb0, x1 = acc[ai][bj][m][1] + bb1;
                    float v[8] = {x0[0], x0[1], x0[2], x0[3], x1[0], x1[1], x1[2], x1[3]};
                    if (act) {
#pragma unroll
                        for (int j = 0; j < 8; ++j) v[j] = c0 * sigmoidf_(v[j]);
                    }
                    *(u32x4*)(D + (size_t)row * 256 + ch) = pk8(v);
                }
        }
    }
};
struct EpiMla {
    const float* ssq_q; const float* ssq_kv; const int* pos; bf16_t* QM; bf16_t* KN; bf16_t* VTM;
    __device__ __forceinline__ void operator()(const Acc& acc, const Unit& u, int wr, int wc, int fr, int fq) const {
        float inv[4];
#pragma unroll
        for (int q = 0; q < 4; ++q) inv[q] = exp2f(-(float)(4 * fq + q) * (13.287712379549449f / 16.0f));
#pragma unroll
        for (int bj = 0; bj < 2; ++bj) {
            const int n0 = u.pn * BM + bj * HALF + wc * 32;
            if (n0 >= 896) continue;
            const bool isq = n0 < 384;
            const bool isrope = isq && ((n0 >> 5) % 3 == 2);
            const int nn = n0 - 384, hh = nn >> 7, c0 = nn & 127;
#pragma unroll
            for (int ai = 0; ai < 2; ++ai)
#pragma unroll
                for (int m = 0; m < 4; ++m) {
                    const int row = u.pm * BM + ai * HALF + wr * 64 + m * 16 + fr;
                    const float rs = isq ? rsqrtf(sum12(ssq_q + (size_t)row * 16) * (1.0f / 384.0f) + NEPS) : rsqrtf(sum4(ssq_kv + (size_t)row * 4) * (1.0f / 128.0f) + NEPS);
                    float v[8];
#pragma unroll
                    for (int n = 0; n < 2; ++n)
#pragma unroll
                        for (int j = 0; j < 4; ++j) v[4 * n + j] = acc[ai][bj][m][n][j] * rs;
                    if (isq) {
                        if (isrope) { const int p = pos[row];
#pragma unroll
                            for (int q = 0; q < 4; ++q) { float c, s; rope_cs(p, inv[q], c, s); const float x1 = v[2 * q], x2 = v[2 * q + 1]; v[2 * q] = x1 * c - x2 * s; v[2 * q + 1] = x1 * s + x2 * c; } }
                        *(u32x4*)(QM + (size_t)row * 384 + n0 + fq * 8) = pk8(v);
                    } else if (c0 < 64) {
                        *(u32x4*)(KN + (size_t)row * 256 + hh * 64 + c0 + fq * 8) = pk8(v);
                    } else {
                        const int b = row >> 11, t = row & 2047, dv0 = c0 - 64 + 8 * fq;
                        bf16_t* vt = VTM + ((size_t)((b * 4 + hh) * 64 + dv0)) * SEQ + t;
#pragma unroll
                        for (int j = 0; j < 8; ++j) vt[(size_t)j * SEQ] = (bf16_t)f2bf(v[j]);
                    }
                    __builtin_amdgcn_sched_barrier(0);
                }
        }
    }
};
}

template <int MODE>
__device__ __forceinline__ void attn_unit(LAS unsigned char* lds, unsigned char* ws, const float* gn_g, int unit, const int tid, const int ocol = U_TG) {
    constexpr int DQK = MODE == 0 ? 96 : 64, NS = DQK / 16, KS = (DQK + 8) * 2, VS = 136, KBUF = 64 * KS, VBUF = 64 * VS, CPR = DQK / 8, NKC = 64 * CPR;
    const int wid = tid >> 6, lane = tid & 63, ql = lane & 31, hi = lane >> 5;
    const int b = unit >> 5, h = (unit >> 3) & 3, qb = unit & 7;
    const int tok0 = b * SEQ, qi = qb * 256 + wid * 32 + ql;
    bf16_t* U = (bf16_t*)(ws + WS_U);
    const bf16_t* QM = (const bf16_t*)(ws + WS_QM); const bf16_t* KN = (const bf16_t*)(ws + WS_KN); const bf16_t* KR = (const bf16_t*)(ws + WS_KR);
    const bf16_t* VT = (const bf16_t*)(ws + (MODE == 0 ? WS_VTM : WS_VTR)) + (size_t)((b * 4 + h) * 64) * SEQ;
    bf16x8 qf[NS];
    { const bf16_t* qrow = MODE == 0 ? QM + (size_t)(tok0 + qi) * 384 + h * 96 : U + (size_t)(tok0 + qi) * NU + U_TQ + h * 64;
#pragma unroll
      for (int s = 0; s < NS; ++s) qf[s] = *(const bf16x8*)(qrow + 16 * s + 8 * hi); }
    const int kc0 = tid, kc1 = tid + 512;
    const int vdv = tid >> 3, vcc = tid & 7;
    u32x4 kreg0, kreg1 = {0, 0, 0, 0}, vreg;
    auto kaddr = [&](int c, int j0) -> const bf16_t* {
        const int key = c / CPR, cc = c % CPR; const size_t tok = (size_t)(tok0 + j0 + key);
        if (MODE == 0) return cc < 8 ? KN + tok * 256 + h * 64 + cc * 8 : KR + tok * 32 + (cc - 8) * 8;
        return U + tok * NU + U_TK + h * 64 + cc * 8;
    };
    auto gload = [&](int j0) {
        kreg0 = *(const u32x4*)kaddr(kc0, j0);
        if (kc1 < NKC) kreg1 = *(const u32x4*)kaddr(kc1, j0);
        vreg = *(const u32x4*)(VT + (size_t)vdv * SEQ + j0 + vcc * 8);
    };
    auto lwrite = [&](int buf) {
        LAS unsigned char* kb = lds + buf * KBUF; LAS unsigned char* vb = lds + 2 * KBUF + buf * VBUF;
        *(LAS u32x4*)(kb + (kc0 / CPR) * KS + (kc0 % CPR) * 16) = kreg0;
        if (kc1 < NKC) *(LAS u32x4*)(kb + (kc1 / CPR) * KS + (kc1 % CPR) * 16) = kreg1;
        *(LAS u32x2*)(vb + vdv * VS + vcc * 16) = (u32x2){vreg.x, vreg.y};
        *(LAS u32x2*)(vb + vdv * VS + vcc * 16 + 8) = (u32x2){vreg.z, vreg.w};
    };
    f32x16 ot[2];
#pragma unroll
    for (int i = 0; i < 16; ++i) { ot[0][i] = 0.f; ot[1][i] = 0.f; }
    float mrun = -1e30f, lrun = 0.f;
    const float lgam = MODE == 1 ? log2f(1.0f - exp2f(-5.0f - (float)h)) : 0.f;
    __syncthreads();
    gload(0); lwrite(0);
    __syncthreads();
    constexpr int NT = SEQ / 64;
    for (int t = 0; t < NT; ++t) {
        const int buf = t & 1;
        if (t + 1 < NT) gload((t + 1) * 64);
        LAS unsigned char* kb = lds + buf * KBUF; LAS unsigned char* vb = lds + 2 * KBUF + buf * VBUF;
        f32x16 st[2];
#pragma unroll
        for (int i = 0; i < 16; ++i) { st[0][i] = 0.f; st[1][i] = 0.f; }
        {
            bf16x8 kfr[2][NS];
#pragma unroll
            for (int kt2 = 0; kt2 < 2; ++kt2)
#pragma unroll
                for (int s = 0; s < NS; ++s) kfr[kt2][s] = *(const LAS bf16x8*)(kb + (32 * kt2 + ql) * KS + (16 * s + 8 * hi) * 2);
            __builtin_amdgcn_sched_barrier(0);
#pragma unroll
            for (int s = 0; s < NS; ++s)
#pragma unroll
                for (int kt2 = 0; kt2 < 2; ++kt2) st[kt2] = __builtin_amdgcn_mfma_f32_32x32x16_bf16(kfr[kt2][s], qf[s], st[kt2], 0, 0, 0);
        }
        u32x4 vfr[2][2][2];
#pragma unroll
        for (int kt2 = 0; kt2 < 2; ++kt2)
#pragma unroll
            for (int s2 = 0; s2 < 2; ++s2)
#pragma unroll
                for (int dt = 0; dt < 2; ++dt) {
                    LAS unsigned char* vp = vb + (32 * dt + ql) * VS + (32 * kt2 + 16 * s2 + 4 * hi) * 2;
                    const u32x2 v0 = *(const LAS u32x2*)vp, v1 = *(const LAS u32x2*)(vp + 16);
                    vfr[kt2][s2][dt] = (u32x4){v0.x, v0.y, v1.x, v1.y};
                }
        __builtin_amdgcn_sched_barrier(0);
        if (MODE == 0) {
            float mx = st[0][0];
#pragma unroll
            for (int i = 0; i < 16; ++i) { mx = fmaxf(mx, st[0][i]); mx = fmaxf(mx, st[1][i]); }
            mx = fmaxf(mx, __shfl_xor(mx, 32));
            const float mnew = fmaxf(mrun, mx), alpha = __builtin_amdgcn_exp2f(mrun - mnew);
            mrun = mnew; float ls = 0.f;
#pragma unroll
            for (int i = 0; i < 16; ++i) { st[0][i] = __builtin_amdgcn_exp2f(st[0][i] - mnew); st[1][i] = __builtin_amdgcn_exp2f(st[1][i] - mnew); ls += st[0][i] + st[1][i]; }
            lrun = lrun * alpha + ls;
            if (__builtin_amdgcn_ballot_w64(alpha != 1.0f)) {
#pragma unroll
                for (int i = 0; i < 16; ++i) { ot[0][i] *= alpha; ot[1][i] *= alpha; }
            }
        } else {
            const float dq = (float)(qi - (t * 64 + 4 * hi));
#pragma unroll
            for (int kt2 = 0; kt2 < 2; ++kt2)
#pragma unroll
                for (int i = 0; i < 16; ++i) { const float d = fabsf(dq - (float)(32 * kt2 + 8 * (i >> 2) + (i & 3))); st[kt2][i] *= __builtin_amdgcn_exp2f(lgam * d); }
        }
        {
#pragma unroll
            for (int kt2 = 0; kt2 < 2; ++kt2)
#pragma unroll
                for (int s2 = 0; s2 < 2; ++s2) {
                    u32x4 pw; pw.x = pk2(st[kt2][8 * s2 + 0], st[kt2][8 * s2 + 1]); pw.y = pk2(st[kt2][8 * s2 + 2], st[kt2][8 * s2 + 3]);
                    pw.z = pk2(st[kt2][8 * s2 + 4], st[kt2][8 * s2 + 5]); pw.w = pk2(st[kt2][8 * s2 + 6], st[kt2][8 * s2 + 7]);
                    const bf16x8 pf = __builtin_bit_cast(bf16x8, pw);
#pragma unroll
                    for (int dt = 0; dt < 2; ++dt) ot[dt] = __builtin_amdgcn_mfma_f32_32x32x16_bf16(__builtin_bit_cast(bf16x8, vfr[kt2][s2][dt]), pf, ot[dt], 0, 0, 0);
                }
        }
        if (t + 1 < NT) lwrite(buf ^ 1);
        __syncthreads();
    }
    const size_t orow = (size_t)(tok0 + qi) * NU;
    if (MODE == 0) {
        const float ltot = lrun + __shfl_xor(lrun, 32), il = 1.0f / ltot;
#pragma unroll
        for (int dt = 0; dt < 2; ++dt)
#pragma unroll
            for (int g = 0; g < 4; ++g) {
                u32x2 w; w.x = pk2(ot[dt][4 * g] * il, ot[dt][4 * g + 1] * il); w.y = pk2(ot[dt][4 * g + 2] * il, ot[dt][4 * g + 3] * il);
                *(u32x2*)(U + orow + U_QA + h * 64 + 32 * dt + 8 * g + 4 * hi) = w;
            }
    } else {
        float sq = 0.f;
#pragma unroll
        for (int i = 0; i < 16; ++i) sq += ot[0][i] * ot[0][i] + ot[1][i] * ot[1][i];
        sq += __shfl_xor(sq, 32);
        const float rs = rsqrtf(sq * (1.0f / 64.0f) + NEPS);
#pragma unroll
        for (int dt = 0; dt < 2; ++dt)
#pragma unroll
            for (int g = 0; g < 4; ++g) {
                const int dv = 32 * dt + 8 * g + 4 * hi;
                bf16_t* gp = U + orow + U_TG + h * 64 + dv;
                const u32x2 gw = *(const u32x2*)gp;
                const float g0 = bflo(gw.x), g1 = bfhi(gw.x), g2 = bflo(gw.y), g3 = bfhi(gw.y);
                const f32x4 gg = *(const f32x4*)(gn_g + h * 64 + dv);
                const float o0 = ot[dt][4 * g] * rs * gg[0] * g0 * sigmoidf_(g0), o1 = ot[dt][4 * g + 1] * rs * gg[1] * g1 * sigmoidf_(g1);
                const float o2 = ot[dt][4 * g + 2] * rs * gg[2] * g2 * sigmoidf_(g2), o3 = ot[dt][4 * g + 3] * rs * gg[3] * g3 * sigmoidf_(g3);
                u32x2 w; w.x = pk2(o0, o1); w.y = pk2(o2, o3);
                *(u32x2*)(U + orow + ocol + h * 64 + dv) = w;
            }
    }
}

struct ScOp { f32x4 w4, kk, nb, kd, r4; float v1; };
#define SC_LD(x, s) do { asm volatile("ds_read_b128 %0, %1 offset:%2" : "=v"(x.w4) : "v"(ao), "n"((s) * 1280)); asm volatile("ds_read_b128 %0, %1 offset:%2" : "=v"(x.kk) : "v"(ao), "n"((s) * 1280 + 256)); \
        asm volatile("ds_read_b128 %0, %1 offset:%2" : "=v"(x.nb) : "v"(ao), "n"((s) * 1280 + 512)); asm volatile("ds_read_b128 %0, %1 offset:%2" : "=v"(x.kd) : "v"(ao), "n"((s) * 1280 + 768)); \
        asm volatile("ds_read_b128 %0, %1 offset:%2" : "=v"(x.r4) : "v"(ao), "n"((s) * 1280 + 1024)); asm volatile("ds_read_b32 %0, %1 offset:%2" : "=v"(x.v1) : "v"(av), "n"((s) * 128)); } while (0)
#define SC_WAIT(x, n) asm volatile("s_waitcnt lgkmcnt(" #n ")" : "+v"(x.w4), "+v"(x.kk), "+v"(x.nb), "+v"(x.kd), "+v"(x.r4), "+v"(x.v1) :: "memory")
#define SC_UPD(x) do { p[0] = __builtin_fmaf(sa, x.nb[0], __builtin_fmaf(p[0], x.w4[0], x.v1 * x.kd[0])); p[1] = __builtin_fmaf(sa, x.nb[1], __builtin_fmaf(p[1], x.w4[1], x.v1 * x.kd[1])); \
        p[2] = __builtin_fmaf(sa, x.nb[2], __builtin_fmaf(p[2], x.w4[2], x.v1 * x.kd[2])); p[3] = __builtin_fmaf(sa, x.nb[3], __builtin_fmaf(p[3], x.w4[3], x.v1 * x.kd[3])); \
        ycar = __builtin_fmaf(p[3], x.r4[3], __builtin_fmaf(p[2], x.r4[2], __builtin_fmaf(p[1], x.r4[1], p[0] * x.r4[0]))); } while (0)
#define SC_MATH0(x) do { float sa = __builtin_fmaf(p[3], x.kk[3], __builtin_fmaf(p[2], x.kk[2], __builtin_fmaf(p[1], x.kk[1], p[0] * x.kk[0]))); sa = rowsum16(sa); SC_UPD(x); } while (0)
#define SC_MATH(x, s) do { float sa = __builtin_fmaf(p[3], x.kk[3], __builtin_fmaf(p[2], x.kk[2], __builtin_fmaf(p[1], x.kk[1], p[0] * x.kk[0]))); \
        sa += dppf<0xB1>(sa); ycar += dppf<0xB1>(ycar); sa += dppf<0x4E>(sa); ycar += dppf<0x4E>(ycar); sa += dppf<0x124>(sa); ycar += dppf<0x124>(ycar); sa += dppf<0x128>(sa); ycar += dppf<0x128>(ycar); \
        *(LAS float*)(yo + ((s) - 1) * 128) = ycar; SC_UPD(x); } while (0)
#define SC_STEP(cur, nxt, s, n) do { SC_LD(nxt, (s) + 1); SC_WAIT(cur, n); SC_MATH(cur, s); } while (0)
#define SC_STEP4(s) do { SC_STEP(ca, cb, s, 7); SC_STEP(cb, ca, (s) + 1, 7); SC_STEP(ca, cb, (s) + 2, 7); SC_STEP(cb, ca, (s) + 3, 7); } while (0)
__device__ __forceinline__ void rwkv_scan(LAS unsigned char* lds, unsigned char* ws, const float* k_k, const float* k_a, int sidx, const int tid) {
    constexpr int TC = 32, OPB = TC * 5 * 64 * 4, VVB = TC * 32 * 4, YOB = TC * 32 * 4;
    const int wid = tid >> 6, lane = tid & 63;
    const int scan = sidx >> 1, hb = sidx & 1, b = scan >> 3, h = (scan >> 1) & 3, dir = scan & 1;
    const bf16_t* U = (const bf16_t*)(ws + WS_U);
    const bf16_t* E = (const bf16_t*)(ws + (dir ? WS_EB : WS_EF)); const bf16_t* A = (const bf16_t*)(ws + (dir ? WS_AB : WS_AF));
    bf16_t* Y = (bf16_t*)(ws + (dir ? WS_YB : WS_YF));
    LAS unsigned char* ops = lds; LAS unsigned char* vvb = lds + 2 * OPB; LAS unsigned char* yob = lds + 2 * OPB + 2 * VVB;
    const int ts = tid >> 4, cj = tid & 15, ch = h * 64 + 4 * cj;
    const f32x4 kk_w = *(const f32x4*)(k_k + ch), ka_w = *(const f32x4*)(k_a + ch);
    struct G { u32x2 rk, rr, rv, re, ra; };
    auto gload = [&](int c) -> G {
        G g;
        const int sI = c * TC + ts, t = dir ? (SEQ - 1 - sI) : sI; const size_t row = (size_t)(b * SEQ + t);
        g.rk = *(const u32x2*)(U + row * NU + U_RK + ch); g.rr = *(const u32x2*)(U + row * NU + U_RR + ch); g.rv = *(const u32x2*)(U + row * NU + U_RV + ch);
        g.re = *(const u32x2*)(E + row * 256 + ch); g.ra = *(const u32x2*)(A + row * 256 + ch);
        return g;
    };
    auto lwrite = [&](int buf, const G& g) {
        const u32x2 rk = g.rk, rr = g.rr, rv = g.rv, re = g.re, ra = g.ra;
        const f32x4 k4 = {bflo(rk.x), bfhi(rk.x), bflo(rk.y), bfhi(rk.y)}, r4 = {bflo(rr.x), bfhi(rr.x), bflo(rr.y), bfhi(rr.y)}, v4 = {bflo(rv.x), bfhi(rv.x), bflo(rv.y), bfhi(rv.y)};
        const f32x4 e4 = {bflo(re.x), bfhi(re.x), bflo(re.y), bfhi(re.y)}, a4 = {bflo(ra.x), bfhi(ra.x), bflo(ra.y), bfhi(ra.y)};
        f32x4 kk = k4 * kk_w;
        float ss = kk[0] * kk[0] + kk[1] * kk[1] + kk[2] * kk[2] + kk[3] * kk[3];
        ss = rowsum16(ss);
        const float nrm = __builtin_amdgcn_rcpf(fmaxf(__builtin_amdgcn_sqrtf(ss), 1e-12f));
        kk = kk * nrm;
        const f32x4 nb = -(kk * a4);
        f32x4 w4; w4[0] = __expf(-e4[0]); w4[1] = __expf(-e4[1]); w4[2] = __expf(-e4[2]); w4[3] = __expf(-e4[3]);
        const f32x4 kd = k4 * (1.0f + (a4 - 1.0f) * ka_w);
        LAS unsigned char* o = ops + buf * OPB + ts * 1280 + cj * 16;
        *(LAS f32x4*)(o) = w4; *(LAS f32x4*)(o + 256) = kk; *(LAS f32x4*)(o + 512) = nb; *(LAS f32x4*)(o + 768) = kd; *(LAS f32x4*)(o + 1024) = r4;
        if ((cj >> 3) == hb) *(LAS f32x4*)(vvb + buf * VVB + ts * 128 + (cj & 7) * 16) = v4;
    };
    auto flush = [&](int c) {
#pragma unroll
        for (int i = 0; i < 2; ++i) {
            const int idx = tid + i * 512, s = idx >> 5, ri = idx & 31;
            const int sI = c * TC + s, t = dir ? (SEQ - 1 - sI) : sI;
            const float yv = *(const LAS float*)(yob + (c & 1) * YOB + s * 128 + ri * 4);
            Y[(size_t)(b * SEQ + t) * 256 + h * 64 + 32 * hb + ri] = (bf16_t)f2bf(yv);
        }
    };
    f32x4 p = {0.f, 0.f, 0.f, 0.f};
    const int rr4 = lane >> 4, lc = lane & 15, rowA = 4 * wid + rr4;
    auto compute = [&](int buf) {
        const unsigned ao = (unsigned)(unsigned long long)(ops + buf * OPB + lc * 16), av = (unsigned)(unsigned long long)(vvb + buf * VVB + rowA * 4);
        LAS unsigned char* yo = yob + buf * YOB + rowA * 4;
        ScOp ca, cb;
        SC_LD(ca, 0);
        float ycar = 0.f;
        SC_LD(cb, 1); SC_WAIT(ca, 6); SC_MATH0(ca); SC_STEP(cb, ca, 1, 6); SC_STEP(ca, cb, 2, 7); SC_STEP(cb, ca, 3, 7);
        SC_STEP4(4); SC_STEP4(8); SC_STEP4(12); SC_STEP4(16); SC_STEP4(20); SC_STEP4(24);
        SC_STEP(ca, cb, 28, 7); SC_STEP(cb, ca, 29, 7); SC_STEP(ca, cb, 30, 7);
        SC_WAIT(cb, 1); SC_MATH(cb, 31);
        ycar = rowsum16(ycar); *(LAS float*)(yo + 31 * 128) = ycar;
    };
    constexpr int NC = SEQ / TC;
    G g0, g1;
    __syncthreads();
    { const G t0 = gload(0); lwrite(0, t0); g0 = gload(1); g1 = gload(2); }
    __syncthreads();
    for (int c = 0; c < NC; c += 2) {
        compute(0); lwrite(1, g0); if (c + 3 < NC) g0 = gload(c + 3);
        __syncthreads();
        flush(c);
        compute(1); if (c + 2 < NC) { lwrite(0, g1); if (c + 4 < NC) g1 = gload(c + 4); }
        __syncthreads();
        flush(c + 1);
    }
    __syncthreads();
}

__device__ __forceinline__ const void* ldptr(volatile LAS unsigned long long* t, int i);
template <class F> __device__ __forceinline__ void conv_mat(bf16_t* dst, int N, int K, F f, long gtid, long gthreads) {
    const unsigned nlines = (unsigned)N * (unsigned)(K >> 6);
    const unsigned li0 = (unsigned)(gtid >> 3), dli = (unsigned)(gthreads >> 3), sub = (unsigned)gtid & 7u;
    unsigned n = li0 % (unsigned)N, kl = li0 / (unsigned)N;
    const unsigned dn = dli % (unsigned)N, dk = dli / (unsigned)N;
    unsigned li = li0;
    for (; li + 3u * dli < nlines; li += 4u * dli) {
        unsigned nn[4], kk[4];
#pragma unroll
        for (int q = 0; q < 4; ++q) { nn[q] = n; kk[q] = kl; n += dn; kl += dk; if (n >= (unsigned)N) { n -= (unsigned)N; ++kl; } }
        float v0[8], v1[8], v2[8], v3[8];
        f((int)nn[0], (int)(sub + 8u * kk[0]) * 8, v0); f((int)nn[1], (int)(sub + 8u * kk[1]) * 8, v1);
        f((int)nn[2], (int)(sub + 8u * kk[2]) * 8, v2); f((int)nn[3], (int)(sub + 8u * kk[3]) * 8, v3);
        *(u32x4*)(dst + (size_t)nn[0] * K + (sub + 8u * kk[0]) * 8) = pk8(v0); *(u32x4*)(dst + (size_t)nn[1] * K + (sub + 8u * kk[1]) * 8) = pk8(v1);
        *(u32x4*)(dst + (size_t)nn[2] * K + (sub + 8u * kk[2]) * 8) = pk8(v2); *(u32x4*)(dst + (size_t)nn[3] * K + (sub + 8u * kk[3]) * 8) = pk8(v3);
    }
    for (; li < nlines; li += dli) {
        const int kc = (int)(sub + 8u * kl);
        float v[8];
        f((int)n, kc * 8, v);
        *(u32x4*)(dst + (size_t)n * K + kc * 8) = pk8(v);
        n += dn; kl += dk; if (n >= (unsigned)N) { n -= (unsigned)N; ++kl; }
    }
}
typedef const __attribute__((address_space(1))) float* gfp_t;
#define GLD(p, i) (((gfp_t)(p))[(i)])
__device__ __forceinline__ void convert_region_a(volatile LAS unsigned long long* ptab, int l, long gtid, long gth) {
    unsigned char* ws = (unsigned char*)ldptr(ptab, 35);
    {
        const float* wg = ((const float*)ldptr(ptab, 3)) + (size_t)l * DM * FF; const float* wu = ((const float*)ldptr(ptab, 4)) + (size_t)l * DM * FF; const float* nr = ((const float*)ldptr(ptab, 2)) + l * DM;
        conv_mat((bf16_t*)(ws + WS_WGU1), 2 * FF, DM, [=](int n, int k0, float* v) { const int pn = n >> 8, rr = n & 255; const float* src = (rr >> 7) ? wu : wg; const int j = pn * 128 + (rr & 127);
#pragma unroll
            for (int i = 0; i < 8; ++i) v[i] = GLD(src, (size_t)(k0 + i) * FF + j) * GLD(nr, k0 + i); }, gtid, gth);
    }
    {   const float* wd = ((const float*)ldptr(ptab, 5)) + (size_t)l * FF * DM;
        conv_mat((bf16_t*)(ws + WS_WD1), DM, FF, [=](int n, int k0, float* v) {
#pragma unroll
            for (int i = 0; i < 8; ++i) v[i] = GLD(wd, (size_t)(k0 + i) * DM + n); }, gtid, gth);
    }
    {
        const float* wi = ((const float*)ldptr(ptab, 7)) + (size_t)l * DM * INW; const float* nr = ((const float*)ldptr(ptab, 6)) + l * DM;
        conv_mat((bf16_t*)(ws + WS_WIN), NU, DM, [=](int n, int k0, float* v) {
            int s; float sc = 1.f;
            if (n < 768) s = n;
            else if (n < 1024) s = 1024 + (n - 768);
            else if (n < 1280) s = 768 + (n - 1024);
            else if (n < 1536) s = n;
            else if (n < 1792) { const int j = n - 1536, c = j & 63; s = 1920 + (j & ~63) + (c >> 1) + 32 * (c & 1); }
            else if (n < 2048) s = 2688 + (n - 1792);
            else if (n < 2304) { const int j = n - 2048, c = j & 63; s = 2176 + (j & ~63) + (c >> 1) + 32 * (c & 1); sc = 0.125f; }
            else if (n < 2560) s = 2432 + (n - 2304);
            else if (n < 2944) s = 2944 + (n - 2560);
            else if (n < 3072) s = 3328 + (n - 2944);
            else if (n < 3456) s = 1536 + (n - 3072);
            else if (n < 3488) { const int c = n - 3456; s = 3456 + (c >> 1) + 16 * (c & 1); }
            else { s = 0; sc = 0.f; }
#pragma unroll
            for (int i = 0; i < 8; ++i) v[i] = GLD(wi, (size_t)(k0 + i) * INW + s) * GLD(nr, k0 + i) * sc; }, gtid, gth);
    }
    {
        const float* w2f = ((const float*)ldptr(ptab, 12)) + l * 64 * 256; const float* w2b = ((const float*)ldptr(ptab, 13)) + l * 64 * 256; const float* a2f = ((const float*)ldptr(ptab, 16)) + l * 64 * 256; const float* a2b = ((const float*)ldptr(ptab, 17)) + l * 64 * 256; const float* g2 = ((const float*)ldptr(ptab, 18)) + l * 128 * 256;
        conv_mat((bf16_t*)(ws + WS_WLORA), 1280, 384, [=](int n, int k0, float* v) {
            const int comp = n >> 8, c = n & 255; const float* src = w2f; int kr = 0; float m = 0.f;
            if (comp == 0 && k0 < 64) { src = w2f; kr = k0; m = 1.f; } else if (comp == 1 && k0 >= 64 && k0 < 128) { src = w2b; kr = k0 - 64; m = 1.f; }
            else if (comp == 2 && k0 >= 128 && k0 < 192) { src = a2f; kr = k0 - 128; m = 1.f; } else if (comp == 3 && k0 >= 192 && k0 < 256) { src = a2b; kr = k0 - 192; m = 1.f; }
            else if (comp == 4 && k0 >= 256) { src = g2; kr = k0 - 256; m = 1.f; }
#pragma unroll
            for (int i = 0; i < 8; ++i) v[i] = GLD(src, (size_t)(kr + i) * 256 + c) * m; }, gtid, gth);
    }
    {
        const float* qb = ((const float*)ldptr(ptab, 26)) + (size_t)l * 384 * 384; const float* qn = ((const float*)ldptr(ptab, 25)) + l * 384; const float* kvb = ((const float*)ldptr(ptab, 28)) + (size_t)l * 128 * 512; const float* kvn = ((const float*)ldptr(ptab, 27)) + l * 128;
        const float qscale = 0.10206207261596577f * 1.4426950408889634f;
        conv_mat((bf16_t*)(ws + WS_WMLA), 1024, 512, [=](int n, int k0, float* v) {
            const float* wp = qb; const float* np = qn; int stride = 384, col = 0, kr = 0; float m = 0.f;
            if (n < 384 && k0 < 384) { const int hh = n / 96, c = n % 96; int sc = c; if (c >= 64) { const int cc = c - 64; sc = 64 + (cc >> 1) + 16 * (cc & 1); }
                col = hh * 96 + sc; kr = k0; m = qscale; }
            else if (n >= 384 && n < 896 && k0 >= 384) { wp = kvb; np = kvn; stride = 512; col = n - 384; kr = k0 - 384; m = 1.f; }
#pragma unroll
            for (int i = 0; i < 8; ++i) v[i] = GLD(wp, (size_t)(kr + i) * stride + col) * GLD(np, kr + i) * m; }, gtid, gth);
    }
}
__device__ __forceinline__ void convert_region_b(volatile LAS unsigned long long* ptab, int l, long gtid, long gth) {
    unsigned char* ws = (unsigned char*)ldptr(ptab, 35);
    {   const float* wo = ((const float*)ldptr(ptab, 8)) + (size_t)l * DM * DM;
        conv_mat((bf16_t*)(ws + WS_WOUT), DM, DM, [=](int n, int k0, float* v) {
#pragma unroll
            for (int i = 0; i < 8; ++i) v[i] = GLD(wo, (size_t)(k0 + i) * DM + n); }, gtid, gth);
    }
    {   const float* wg = ((const float*)ldptr(ptab, 30)) + (size_t)l * DM * FF; const float* wu = ((const float*)ldptr(ptab, 31)) + (size_t)l * DM * FF; const float* nr = ((const float*)ldptr(ptab, 29)) + l * DM;
        conv_mat((bf16_t*)(ws + WS_WGU2), 2 * FF, DM, [=](int n, int k0, float* v) { const int pn = n >> 8, rr = n & 255; const float* src = (rr >> 7) ? wu : wg; const int j = pn * 128 + (rr & 127);
#pragma unroll
            for (int i = 0; i < 8; ++i) v[i] = GLD(src, (size_t)(k0 + i) * FF + j) * GLD(nr, k0 + i); }, gtid, gth);
    }
    {   const float* wd = ((const float*)ldptr(ptab, 32)) + (size_t)l * FF * DM;
        conv_mat((bf16_t*)(ws + WS_WD2), DM, FF, [=](int n, int k0, float* v) {
#pragma unroll
            for (int i = 0; i < 8; ++i) v[i] = GLD(wd, (size_t)(k0 + i) * DM + n); }, gtid, gth);
    }
}


#define XB_TMO      128
#define XB_XCNT(j)  (256  + 64 * (j))
#define XB_XSUB(j)  (1280 + 64 * (j))
#define XB_XGEN(j)  (2304 + 64 * (j))
#define XB_TOP      3328
#define XB_TOPGEN   3392
#define XCD_BAR_WORDS 3456
#define XB_SPIN_CAP (1u << 22)
__device__ __forceinline__ unsigned xb_ld(unsigned* p)              { return __hip_atomic_load(p, __ATOMIC_RELAXED, __HIP_MEMORY_SCOPE_AGENT); }
__device__ __forceinline__ unsigned xb_add(unsigned* p, unsigned v) { return __hip_atomic_fetch_add(p, v, __ATOMIC_RELAXED, __HIP_MEMORY_SCOPE_AGENT); }
__device__ __forceinline__ unsigned xb_xcc_id() { return (unsigned)__builtin_amdgcn_s_getreg((3 << 11) | 20) & 0xFu; }
#define XB_SPIN(cond, bar) do { unsigned _sp = 0; while (cond) { __builtin_amdgcn_s_sleep(1); \
    if ((++_sp & 255u) == 0u) { if (xb_ld(&(bar)[XB_TMO])) break; if (_sp > XB_SPIN_CAP) { atomicAdd(&(bar)[XB_TMO], 1u); break; } } } } while (0)
struct XcdBarrier { unsigned* bar; unsigned x; volatile LAS unsigned* st; };
__device__ __forceinline__ XcdBarrier xcd_barrier_post(unsigned* bar, volatile LAS unsigned* st) {
    XcdBarrier b; b.bar = bar; b.x = xb_xcc_id(); b.st = st;
    if (threadIdx.x == 0) (void)xb_add(&bar[XB_XCNT(b.x)], 1u);
    return b;
}
__device__ __forceinline__ void xcd_barrier_complete(unsigned* bar, unsigned x, unsigned& nloc, unsigned& nx) {
    const unsigned G = gridDim.x * gridDim.y * gridDim.z;
    unsigned sum, cnt, mine, sp = 0u;
    for (;;) {
        sum = 0u; cnt = 0u; mine = 0u;
#pragma unroll
        for (unsigned j = 0; j < 16; ++j) { const unsigned c = xb_ld(&bar[XB_XCNT(j)]); sum += c; cnt += (c > 0u) ? 1u : 0u; mine = (j == x) ? c : mine; }
        if (sum == G) break;
        __builtin_amdgcn_s_sleep(1);
        if ((++sp & 255u) == 0u) { if (xb_ld(&bar[XB_TMO])) break; if (sp > XB_SPIN_CAP) { atomicAdd(&bar[XB_TMO], 1u); break; } }
    }
    nloc = mine > 0u ? mine : 1u; nx = cnt > 0u ? cnt : 1u;
}
__device__ __forceinline__ void xcd_barrier(const XcdBarrier& b) {
    asm volatile("s_waitcnt vmcnt(0)" ::: "memory");
    __syncthreads();
    if (threadIdx.x == 0) {
        unsigned* bar = b.bar;
        __builtin_amdgcn_s_waitcnt(0);
        unsigned nloc = b.st[0], nx = b.st[1];
        if (nloc == 0u) { xcd_barrier_complete(bar, b.x, nloc, nx); b.st[0] = nloc; b.st[1] = nx; }
        const unsigned old = xb_add(&bar[XB_XSUB(b.x)], 1u);
        const unsigned gen = old / nloc;
        if (old + 1u == (gen + 1u) * nloc) {
            __builtin_amdgcn_fence(__ATOMIC_RELEASE, "agent");
            asm volatile("s_waitcnt vmcnt(0)" ::: "memory");
            const unsigned og = xb_add(&bar[XB_TOP], 1u);
            const unsigned tg = og / nx;
            if (og + 1u == (tg + 1u) * nx) xb_add(&bar[XB_TOPGEN], 1u);
            else XB_SPIN(xb_ld(&bar[XB_TOPGEN]) == tg, bar);
            __builtin_amdgcn_fence(__ATOMIC_ACQUIRE, "agent");
            xb_add(&bar[XB_XGEN(b.x)], 1u);
            asm volatile("s_waitcnt vmcnt(0)" ::: "memory");
        } else {
            XB_SPIN(xb_ld(&bar[XB_XGEN(b.x)]) == gen, bar);
            __builtin_amdgcn_fence(__ATOMIC_ACQUIRE, "agent");
            asm volatile("s_waitcnt vmcnt(0)" ::: "memory");
        }
    }
    __syncthreads();
}

constexpr int PTAB_OFF = 143360;
__device__ __forceinline__ const void* ldptr(volatile LAS unsigned long long* t, int i) {
    const unsigned long long v = t[i];
    const unsigned lo = __builtin_amdgcn_readfirstlane((unsigned)v), hi = __builtin_amdgcn_readfirstlane((unsigned)(v >> 32));
    return (const void*)(const __attribute__((address_space(1))) void*)(((unsigned long long)hi << 32) | lo);
}
#ifndef PHMASK
#define PHMASK 0xFFFF
#endif
#define PHON(i) ((PHMASK >> (i)) & 1)
#ifndef REPMASK
#define REPMASK 0
#endif
#define NREP(i) (((REPMASK >> (i)) & 1) ? 2 : 1)
__global__ void __launch_bounds__(512, 2) fwd_kernel(Args a) {
    extern __shared__ __attribute__((aligned(16))) unsigned char smem_raw[];
    LAS unsigned char* lds = (LAS unsigned char*)smem_raw;
    cg::grid_group grid = cg::this_grid();
    const int nb = gridDim.x, bid = blockIdx.x;
    volatile LAS unsigned long long* ptab = (volatile LAS unsigned long long*)(lds + PTAB_OFF);
    if (threadIdx.x == 0) {
#pragma unroll
        for (int i = 0; i < 34; ++i) ptab[i] = (unsigned long long)a.in[i];
        ptab[34] = (unsigned long long)a.out; ptab[35] = (unsigned long long)a.ws;
        ((volatile LAS unsigned*)(lds + PTAB_OFF + 512))[0] = 0u; ((volatile LAS unsigned*)(lds + PTAB_OFF + 512))[1] = 0u;
    }
    __syncthreads();
    { const XcdBarrier xb0 = xcd_barrier_post((unsigned*)a.ws, (volatile LAS unsigned*)(lds + PTAB_OFF + 512)); if (threadIdx.x == 0) ((volatile LAS unsigned*)(lds + PTAB_OFF + 512))[2] = xb0.x; }
    __syncthreads();
    const int ph_lo = a.ph_lo, ph_hi = a.ph_hi;
#define INP(i) ((const float*)ldptr(ptab, (i)))

    for (int ph = ph_lo; ph < ph_hi; ++ph) {
        unsigned char* ws = (unsigned char*)ldptr(ptab, 35);
        float* const outp = (float*)ldptr(ptab, 34);
        const int* pos = (const int*)INP(1);
        int tid = threadIdx.x; asm volatile("" : "+v"(tid));
        const int wid = tid >> 6, lane = tid & 63;
        const long gtid = (long)bid * 512 + tid, gth = (long)nb * 512;
        float* ssq = (float*)(ws + WS_SSQP);
        float* sqq = (float*)(ws + WS_SQQ); float* sqkv = (float*)(ws + WS_SQKV);
#define SSQI(i) (ssq + (size_t)((i) & 1) * MTOK * 16)
        bf16_t* XB = (bf16_t*)(ws + WS_XB); bf16_t* U = (bf16_t*)(ws + WS_U);
        if (PHON(0) && ph == 0) {
          for (int rep = 0; rep < NREP(0); ++rep) {
            for (int row = bid * 8 + wid; row < MTOK; row += nb * 8) {
                const float* xr = INP(0) + (size_t)row * DM; float sq = 0.f;
#pragma unroll
                for (int i = 0; i < 2; ++i) {
                    const int c = i * 512 + lane * 8;
                    const f32x4 x0 = *(const f32x4*)(xr + c), x1 = *(const f32x4*)(xr + c + 4);
                    float v[8] = {x0[0], x0[1], x0[2], x0[3], x1[0], x1[1], x1[2], x1[3]};
#pragma unroll
                    for (int j = 0; j < 8; ++j) sq += v[j] * v[j];
                    *(u32x4*)(XB + (size_t)row * DM + c) = pk8(v);
                }
                sq = wavesum(sq);
                if (lane == 0) { float* sp = ssq + (size_t)row * 16; *(f32x4*)sp = (f32x4){sq, 0.f, 0.f, 0.f}; *(f32x4*)(sp + 4) = (f32x4){0.f, 0.f, 0.f, 0.f}; *(f32x4*)(sp + 8) = (f32x4){0.f, 0.f, 0.f, 0.f}; *(f32x4*)(sp + 12) = (f32x4){0.f, 0.f, 0.f, 0.f}; }
            }
            convert_region_a(ptab, 0, gtid, gth);
            if (nb < 256) convert_region_b(ptab, 0, gtid, gth);
          }
        } else if (PHON(1) && ph == 19) {
            const float* fg = INP(33);
            for (int row = bid * 8 + wid; row < MTOK; row += nb * 8) {
                float* xr = outp + (size_t)row * DM;
                f32x4 xv[4]; float sq = 0.f;
#pragma unroll
                for (int i = 0; i < 4; ++i) { xv[i] = *(const f32x4*)(xr + i * 256 + lane * 4); sq += xv[i][0] * xv[i][0] + xv[i][1] * xv[i][1] + xv[i][2] * xv[i][2] + xv[i][3] * xv[i][3]; }
                sq = wavesum(sq);
                const float rs = rsqrtf(sq * (1.0f / DM) + NEPS);
#pragma unroll
                for (int i = 0; i < 4; ++i) { const int c = i * 256 + lane * 4; const f32x4 g = *(const f32x4*)(fg + c); *(f32x4*)(xr + c) = xv[i] * rs * g; }
            }
        } else {
            const int l = (ph - 1) / 9, k = (ph - 1) % 9;
            pg8::StaticOrder S;
            auto do_conv = [&](long cg0, long cgt) {
                const float* cw = INP(9) + l * 768;
                for (long it = cg0; it < (long)MTOK * 32; it += cgt) {
                    const int tok = (int)(it >> 5), c8 = (int)(it & 31) * 8, t = tok & (SEQ - 1);
                    float acc8[8] = {0.f, 0.f, 0.f, 0.f, 0.f, 0.f, 0.f, 0.f};
#pragma unroll
                    for (int j = 0; j < 3; ++j) {
                        const int tt = t + j - 1;
                        if (tt >= 0 && tt < SEQ) {
                            const bf16_t* ur = U + (size_t)(tok + j - 1) * NU;
                            float cx[8], cc[8]; unpk8(*(const u32x4*)(ur + U_CX + c8), cx); unpk8(*(const u32x4*)(ur + U_CC + c8), cc);
#pragma unroll
                            for (int i = 0; i < 8; ++i) acc8[i] += cw[j * 256 + c8 + i] * (cx[i] * cc[i]);
                        }
                    }
                    bf16_t* bp = U + (size_t)tok * NU + U_CB + c8; float cb[8]; unpk8(*(const u32x4*)bp, cb);
#pragma unroll
                    for (int i = 0; i < 8; ++i) acc8[i] *= cb[i];
                    *(u32x4*)bp = pk8(acc8);
                }
            };
            if (PHON(2) && (k == 0 || k == 7)) {
                const int f2 = (k == 7);
                pg8::Gemm g{XB, (const bf16_t*)(ws + (f2 ? WS_WGU2 : WS_WGU1)), MTOK, 2 * FF, DM, DM, 512};
                pg8::EpiGU E{SSQI(3 * l + (f2 ? 2 : 0)), U};
                S.init(MTOK, 2 * FF, nb, bid);
                for (int rep = 0; rep < NREP(1); ++rep) pg8::gemm_phase(lds, g, S, E, tid);
            } else if (PHON(3) && (k == 1 || k == 8 || k == 6)) {
                pg8::Gemm g; pg8::EpiRes E;
                if (k == 6) { g = pg8::Gemm{U + U_CB, (const bf16_t*)(ws + WS_WOUT), MTOK, DM, DM, NU, 768 * 2}; E = pg8::EpiRes{outp, outp, XB, SSQI(3 * l + 2), 1.0f, 0}; }
                else { const int f2 = (k == 8);
                    g = pg8::Gemm{U, (const bf16_t*)(ws + (f2 ? WS_WD2 : WS_WD1)), MTOK, DM, FF, FF, 512};
                    E = pg8::EpiRes{(l == 0 && !f2) ? INP(0) : outp, outp, XB, SSQI(3 * l + (f2 ? 3 : 1)), 0.5f, 0}; }
                S.init(MTOK, DM, nb, bid);
                { const int nr = (k == 6) ? NREP(9) : NREP(8); for (int rep = 0; rep < nr; ++rep) { E.dry = (rep + 1 < nr) ? 1 : ((k == 8 && l == 1) ? -1 : 0); pg8::gemm_phase(lds, g, S, E, tid); } }
            } else if (PHON(4) && k == 2) {
                pg8::Gemm g{XB, (const bf16_t*)(ws + WS_WIN), MTOK, NU, DM, DM, 512};
                pg8::EpiWin E{SSQI(3 * l + 1), pos, U, sqq, sqkv, (bf16_t*)(ws + WS_KR), (bf16_t*)(ws + WS_VTR)};
                S.init(MTOK, NU, nb, bid);
                for (int rep = 0; rep < NREP(2); ++rep) pg8::gemm_phase(lds, g, S, E, tid);
            } else if (PHON(5) && k == 3) {
                if (PHON(8)) {   pg8::Gemm g{U + U_LORA, (const bf16_t*)(ws + WS_WLORA), MTOK, 1280, 384, NU, 512};
                    pg8::EpiLora E{ws, INP(10) + l * 256, INP(11) + l * 256, INP(14) + l * 256, INP(15) + l * 256};
                    S.init(MTOK, 1280, nb, bid);
                    for (int rep = 0; rep < NREP(3); ++rep) pg8::gemm_phase(lds, g, S, E, tid); }
                if (PHON(9)) {   pg8::Gemm g{U + U_QA, (const bf16_t*)(ws + WS_WMLA), MTOK, 1024, 512, NU, 512};
                    pg8::EpiMla E{sqq, sqkv, pos, (bf16_t*)(ws + WS_QM), (bf16_t*)(ws + WS_KN), (bf16_t*)(ws + WS_VTM)};
                    S.init(MTOK, 1024, nb, bid);
                    for (int rep = 0; rep < NREP(3); ++rep) pg8::gemm_phase(lds, g, S, E, tid); }
                if (PHON(10) && nb < 256) do_conv(gtid, gth);
            } else if (PHON(6) && k == 4) {
                if (nb >= 256 && bid >= 128) do_conv((long)(bid - 128) * 512 + tid, (long)128 * 512);
                for (int rep = 0; rep < NREP(4); ++rep) for (int sx = bid; sx < 128; sx += nb) rwkv_scan(lds, ws, INP(19) + l * 256, INP(20) + l * 256, sx, tid);
                for (int rep = 0; rep < NREP(5); ++rep) {
                    unsigned* ctr = (unsigned*)ws + 3600 + l + 2 * rep;
                    volatile LAS unsigned* uw = (volatile LAS unsigned*)(lds + PTAB_OFF + 640);
                    const float* gng = INP(24) + l * 256;
                    const int ocol = (rep + 1 < NREP(5)) ? U_TV : U_TG;
                    for (;;) {
                        __syncthreads();
                        if (tid == 0) *uw = atomicAdd(ctr, 1u);
                        __syncthreads();
                        const int unit = __builtin_amdgcn_readfirstlane(*uw);
                        if (unit >= 512) break;
                        if (unit < 256) attn_unit<0>(lds, ws, nullptr, unit, tid); else attn_unit<1>(lds, ws, gng, unit - 256, tid, ocol);
                    }
                }
                if (nb >= 256 && bid >= 128) {
                    const long g2 = (long)(bid - 128) * 512 + tid, gt2 = (long)128 * 512;
                    if (l == 0) { convert_region_b(ptab, 0, g2, gt2); convert_region_a(ptab, 1, g2, gt2); } else convert_region_b(ptab, 1, g2, gt2);
                } else if (nb < 256) { if (l == 0) convert_region_a(ptab, 1, gtid, gth); else convert_region_b(ptab, 1, gtid, gth); }
            } else if (PHON(7) && k == 5) {
                const bf16_t* YF = (const bf16_t*)(ws + WS_YF); const bf16_t* YB = (const bf16_t*)(ws + WS_YB);
                const bf16_t* AF = (const bf16_t*)(ws + WS_AF); const bf16_t* AB = (const bf16_t*)(ws + WS_AB); const bf16_t* GG = (const bf16_t*)(ws + WS_GG);
                const float* k_a = INP(20) + l * 256; const float* r_k = INP(21) + l * 256; const float* lg = INP(22) + l * 256; const float* lb = INP(23) + l * 256;
                for (int rep = 0; rep < NREP(7); ++rep)
                for (int gidx = bid * 32 + (tid >> 4); gidx < MTOK * 4; gidx += nb * 32) {
                    const int tok = gidx >> 2, h = gidx & 3, ch = h * 64 + 4 * (tid & 15);
                    const size_t lr = (size_t)tok * 256 + ch; bf16_t* ur = U + (size_t)tok * NU;
                    const u32x2 wf = *(const u32x2*)(YF + lr), wb = *(const u32x2*)(YB + lr);
                    f32x4 y = {bflo(wf.x) + bflo(wb.x), bfhi(wf.x) + bfhi(wb.x), bflo(wf.y) + bflo(wb.y), bfhi(wf.y) + bfhi(wb.y)};
                    const float mu = rowsum16(y[0] + y[1] + y[2] + y[3]) * (1.0f / 64.0f);
                    const f32x4 d = y - mu;
                    const float var = rowsum16(d[0] * d[0] + d[1] * d[1] + d[2] * d[2] + d[3] * d[3]) * (1.0f / 64.0f);
                    const float rsd = rsqrtf(var + 64e-5f);
                    const u32x2 wr_ = *(const u32x2*)(ur + U_RR + ch), wk_ = *(const u32x2*)(ur + U_RK + ch), wv_ = *(const u32x2*)(ur + U_RV + ch);
                    const u32x2 waf = *(const u32x2*)(AF + lr), wab = *(const u32x2*)(AB + lr), wg_ = *(const u32x2*)(GG + lr);
                    const f32x4 r4 = {bflo(wr_.x), bfhi(wr_.x), bflo(wr_.y), bfhi(wr_.y)}, k4 = {bflo(wk_.x), bfhi(wk_.x), bflo(wk_.y), bfhi(wk_.y)}, v4 = {bflo(wv_.x), bfhi(wv_.x), bflo(wv_.y), bfhi(wv_.y)};
                    const f32x4 af = {bflo(waf.x), bfhi(waf.x), bflo(waf.y), bfhi(waf.y)}, ab = {bflo(wab.x), bfhi(wab.x), bflo(wab.y), bfhi(wab.y)}, g4 = {bflo(wg_.x), bfhi(wg_.x), bflo(wg_.y), bfhi(wg_.y)};
                    const f32x4 ka = *(const f32x4*)(k_a + ch), rk = *(const f32x4*)(r_k + ch), lg4 = *(const f32x4*)(lg + ch), lb4 = *(const f32x4*)(lb + ch);
                    const f32x4 ksum = k4 * (2.0f + (af + ab - 2.0f) * ka);
                    const f32x4 pr = r4 * ksum * rk;
                    const float bs = rowsum16(pr[0] + pr[1] + pr[2] + pr[3]);
                    const f32x4 o = (d * rsd * lg4 + lb4 + bs * v4) * g4;
                    u32x2 w; w.x = pk2(o[0], o[1]); w.y = pk2(o[2], o[3]);
                    *(u32x2*)(ur + (rep + 1 < NREP(7) ? U_TV : U_RR) + ch) = w;
                }

            }
        }
        if (ph + 1 < ph_hi) {
            if (ph_hi > 1000) grid.sync();
            { XcdBarrier xb; xb.st = (volatile LAS unsigned*)(lds + PTAB_OFF + 512); xb.bar = (unsigned*)ldptr(ptab, 35); xb.x = __builtin_amdgcn_readfirstlane(xb.st[2]); xcd_barrier(xb); if (NREP(10) > 1) { xcd_barrier(xb); xcd_barrier(xb); } }
        }
    }
}

#ifndef RUNMASK
#define RUNMASK 0xFFFFF
#endif
#ifndef MK_MULTI
#define MK_MULTI 0
#endif
extern "C" void kernel_launch(void* const* d_in, const int* in_sizes, int n_in, void* d_out, int out_size, void* d_ws, size_t ws_size, hipStream_t stream) {
    static int grid = 0;
    if (grid == 0) {
        if (n_in != 34 || ws_size < WS_END) { fprintf(stderr, "kernel_launch: unexpected n_in %d / ws %zu\n", n_in, ws_size); grid = -1; return; }
        if (hipFuncSetAttribute((const void*)fwd_kernel, hipFuncAttributeMaxDynamicSharedMemorySize, LDS_BYTES) != hipSuccess) { fprintf(stderr, "hipFuncSetAttribute failed\n"); grid = -1; return; }
        int dev = 0, cus = 0, per_cu = 0;
        hipGetDevice(&dev); hipDeviceGetAttribute(&cus, hipDeviceAttributeMultiprocessorCount, dev);
        hipOccupancyMaxActiveBlocksPerMultiprocessor(&per_cu, (const void*)fwd_kernel, 512, LDS_BYTES);
        (void)hipGetLastError();
        if (per_cu < 1) fprintf(stderr, "occupancy query says %d blocks per CU\n", per_cu);
        grid = cus > 0 ? cus : 256;
    }
    if (grid < 0) return;
    Args a{};
    for (int i = 0; i < 34; ++i) a.in[i] = (const float*)d_in[i];
    a.out = (float*)d_out; a.ws = (unsigned char*)d_ws;
    if (hipMemsetAsync(d_ws, 0, 16384, stream) != hipSuccess) { fprintf(stderr, "memset failed\n"); return; }
#if MK_MULTI
    for (int p = 0; p < 20; ++p) { if (!((RUNMASK >> p) & 1)) continue; a.ph_lo = p; a.ph_hi = p + 1; hipLaunchKernelGGL(fwd_kernel, dim3(grid), dim3(512), LDS_BYTES, stream, a); }
#else
    a.ph_lo = 0; a.ph_hi = 20;
    void* args[] = {&a};
    hipError_t e = hipLaunchCooperativeKernel((const void*)fwd_kernel, dim3(grid), dim3(512), args, LDS_BYTES, stream);
    if (e != hipSuccess) fprintf(stderr, "cooperative launch failed: %s (grid %d)\n", hipGetErrorString(e), grid);
#endif
}
```

```cpp
#include <hip/hip_runtime.h>
#include <hip/hip_cooperative_groups.h>
#include <cstdint>
#include <cstdio>
namespace cg = cooperative_groups;

#define LAS __attribute__((address_space(3)))
typedef unsigned short bf16_t;
typedef short bf16x8 __attribute__((ext_vector_type(8)));
typedef short s16x4 __attribute__((ext_vector_type(4)));
typedef float f32x4 __attribute__((ext_vector_type(4)));
typedef float f32x16 __attribute__((ext_vector_type(16)));
typedef float f32x2 __attribute__((ext_vector_type(2)));
typedef unsigned u32x4 __attribute__((ext_vector_type(4)));
typedef unsigned u32x2 __attribute__((ext_vector_type(2)));

constexpr int MTOK = 16384, SEQ = 2048, DM = 1024, FF = 2816, NU = 3584, INW = 3488;
constexpr float NEPS = 1e-6f;
constexpr int U_CX = 0, U_CB = 256, U_CC = 512, U_RK = 768, U_RR = 1024, U_RV = 1280, U_TQ = 1536, U_TG = 1792, U_TK = 2048,
              U_TV = 2304, U_QA = 2560, U_CKV = 2944, U_LORA = 3072, U_KR = 3456;
constexpr size_t MiB = 1u << 20;
constexpr size_t WS_SSQ = 0;
constexpr size_t WS_WGU1 = 1 * MiB, WS_WD1 = 12 * MiB, WS_WIN = 17 * MiB + 512 * 1024, WS_WLORA = 24 * MiB + 512 * 1024, WS_WMLA = 25 * MiB + 512 * 1024;
constexpr size_t WS_WOUT = 27 * MiB, WS_WGU2 = 29 * MiB, WS_WD2 = 40 * MiB;
constexpr size_t WS_XB = 46 * MiB;
constexpr size_t WS_YF = 46 * MiB, WS_YB = 54 * MiB, WS_AB = 62 * MiB, WS_GG = 70 * MiB;
constexpr size_t WS_U = 78 * MiB;
constexpr size_t WS_EF = 190 * MiB, WS_EB = 198 * MiB, WS_AF = 206 * MiB;
constexpr size_t WS_QM = 214 * MiB, WS_KN = 226 * MiB, WS_KR = 234 * MiB, WS_VTM = 235 * MiB, WS_VTR = 243 * MiB, WS_END = 255 * MiB;
constexpr size_t WS_SSQP = 251 * MiB, WS_SQQ = 253 * MiB, WS_SQKV = 254 * MiB;
constexpr int LDS_BYTES = 147456;

struct Args { const float* in[34]; float* out; unsigned char* ws; int ph_lo, ph_hi; };

__device__ __forceinline__ unsigned f2bf(float f) { unsigned u = __float_as_uint(f); return (u + 0x7fffu + ((u >> 16) & 1u)) >> 16; }
typedef __bf16 hwbf16x2 __attribute__((ext_vector_type(2)));
__device__ __forceinline__ unsigned pk2(float lo, float hi) { const f32x2 v = {lo, hi}; return __builtin_bit_cast(unsigned, __builtin_convertvector(v, hwbf16x2)); }
__device__ __forceinline__ float bflo(unsigned w) { return __uint_as_float(w << 16); }
__device__ __forceinline__ float bfhi(unsigned w) { return __uint_as_float(w & 0xffff0000u); }
__device__ __forceinline__ u32x4 pk8(const float* v) { u32x4 w; w.x = pk2(v[0], v[1]); w.y = pk2(v[2], v[3]); w.z = pk2(v[4], v[5]); w.w = pk2(v[6], v[7]); return w; }
__device__ __forceinline__ void unpk8(u32x4 w, float* v) { v[0] = bflo(w.x); v[1] = bfhi(w.x); v[2] = bflo(w.y); v[3] = bfhi(w.y); v[4] = bflo(w.z); v[5] = bfhi(w.z); v[6] = bflo(w.w); v[7] = bfhi(w.w); }
__device__ __forceinline__ float sigmoidf_(float x) { return __builtin_amdgcn_rcpf(1.0f + __expf(-x)); }
template <int CTRL> __device__ __forceinline__ float dppf(float x) { return __int_as_float(__builtin_amdgcn_update_dpp(0, __float_as_int(x), CTRL, 0xF, 0xF, true)); }
__device__ __forceinline__ float rowsum16(float x) { x += dppf<0xB1>(x); x += dppf<0x4E>(x); x += dppf<0x124>(x); x += dppf<0x128>(x); return x; }
__device__ __forceinline__ float wavesum(float v) { for (int o = 32; o > 0; o >>= 1) v += __shfl_xor(v, o); return v; }
__device__ __forceinline__ float sum16(const float* p) { const f32x4 a = *(const f32x4*)p, b = *(const f32x4*)(p + 4), c = *(const f32x4*)(p + 8), d = *(const f32x4*)(p + 12);
    return (((a[0] + a[1]) + (a[2] + a[3])) + ((b[0] + b[1]) + (b[2] + b[3]))) + (((c[0] + c[1]) + (c[2] + c[3])) + ((d[0] + d[1]) + (d[2] + d[3]))); }
__device__ __forceinline__ float sum12(const float* p) { const f32x4 a = *(const f32x4*)p, b = *(const f32x4*)(p + 4), c = *(const f32x4*)(p + 8);
    return (((a[0] + a[1]) + (a[2] + a[3])) + ((b[0] + b[1]) + (b[2] + b[3]))) + ((c[0] + c[1]) + (c[2] + c[3])); }
__device__ __forceinline__ float sum4(const float* p) { const f32x4 a = *(const f32x4*)p; return (a[0] + a[1]) + (a[2] + a[3]); }
__device__ __forceinline__ void rope_cs(int p, float inv, float& c, float& s) {
    const float ang = (float)p * inv; const float rev = ang * 0.15915494309189535f; const float fr = rev - floorf(rev);
    c = __builtin_amdgcn_cosf(fr); s = __builtin_amdgcn_sinf(fr);
}

namespace pg8 {
constexpr int BM = 256, BK = 64, HALF = 128, HTB = HALF * BK * 2, NXCD = 8, WGM = 8;
__host__ __device__ __forceinline__ int lds_byte(int r, int c) { const int st = (r >> 4) * 2 + (c >> 5), rr = r & 15, cc = c & 31, ob = rr * 64 + cc * 2; return st * 1024 + (ob ^ (((ob >> 9) & 1) << 5)); }
__host__ __device__ __forceinline__ void stage_rc(int b, int& R, int& C) { const int st = b / 1024, sb = b % 1024, swz = sb ^ (((sb >> 9) & 1) << 5); R = (st >> 1) * 16 + swz / 64; C = (st & 1) * 32 + (swz % 64) / 2; }
__host__ __device__ __forceinline__ int perm32(int rho) { const int n = rho >> 4, i = rho & 15; return 8 * (i >> 2) + 4 * n + (i & 3); }
struct Unit { int pm, pn; };
struct Gemm { const bf16_t* A; const bf16_t* Bt; int M, N, K, lda, kseg; };
struct StaticOrder {
    int nM, nN, nwg, G, c;
    __device__ void init(int M, int N, int G_, int c_) { nM = M / BM; nN = N / BM; nwg = nM * nN; G = G_; c = c_; }
    __device__ bool next(int i, Unit& u) const {
        const long L = (long)i * G + c; if (L >= nwg) return false;
        int wgid = (int)L; { const int q = nwg / NXCD, r = nwg % NXCD, xcd = wgid % NXCD, off = wgid / NXCD; wgid = (xcd < r ? xcd * (q + 1) : r * (q + 1) + (xcd - r) * q) + off; }
        const int nig = WGM * nN, gid = wgid / nig, fm = gid * WGM, gsz = (nM - fm) < WGM ? (nM - fm) : WGM;
        u.pm = fm + ((wgid % nig) % gsz); u.pn = (wgid % nig) / gsz; return true;
    }
};
template <class Epi, class Sched>
__device__ __forceinline__ void gemm_phase(LAS unsigned char* lds, const Gemm g, const Sched& S, const Epi& E, const int tid) {
    const int wid = __builtin_amdgcn_readfirstlane(tid >> 6), lane = tid & 63, wr = wid >> 2, wc = wid & 3, fr = lane & 15, fq = lane >> 4;
    const int K = g.K, nt = K / BK;
    unsigned voffA[2], voffB[2];
#pragma unroll
    for (int i = 0; i < 2; ++i) { int R, C; stage_rc(tid * 16 + i * 8192, R, C); const int Rb = (R & ~31) + perm32(R & 31);
        voffA[i] = (unsigned)(R * g.lda + C) * 2u; voffB[i] = (unsigned)(Rb * K + C) * 2u; }
    const size_t kstep = (size_t)(BK * 2);
    const size_t hstepA = (size_t)HALF * g.lda * 2, tstepA = 2 * hstepA;
    const size_t hstepB = (size_t)HALF * K * 2, tstepB = 2 * hstepB;
    const size_t kseg = (size_t)g.kseg;
    const unsigned ldsw = (unsigned)wid * 1024u;
    const int aoff = lds_byte(wr * 64 + fr, fq * 8), boff = lds_byte(wc * 32 + fr, fq * 8);
#define KOFFA(t) ((size_t)((t) >> 2) * kseg + (size_t)((t) & 3) * kstep)
#define PG8_SA(b, h) (((b) * 2 + (h)) * HTB)
#define PG8_SB(b, h) ((4 + (b) * 2 + (h)) * HTB)
#define PG8_STAGE(bufoff, gbase, voff) do { _Pragma("unroll") for (int _i = 0; _i < 2; ++_i) { unsigned _vo = (voff)[_i]; asm volatile("" : "+v"(_vo)); \
        __builtin_amdgcn_global_load_lds((const unsigned*)((const char*)(gbase) + _vo), (LAS unsigned*)(lds + (bufoff) + ldsw + _i * 8192), 16, 0, 0); } } while (0)
#define PG8_LDA(dst, b, h) do { _Pragma("unroll") for (int m = 0; m < 4; ++m) _Pragma("unroll") for (int k = 0; k < 2; ++k) dst[m][k] = *(const LAS bf16x8*)(lds + PG8_SA(b, h) + aoff + m * 2048 + k * 1024); } while (0)
#define PG8_LDB(dst, b, h) do { _Pragma("unroll") for (int n = 0; n < 2; ++n) _Pragma("unroll") for (int k = 0; k < 2; ++k) dst[n][k] = *(const LAS bf16x8*)(lds + PG8_SB(b, h) + boff + n * 2048 + k * 1024); } while (0)
#define PG8_MMA(ai, bj, At, Bt) do { __builtin_amdgcn_s_setprio(1); _Pragma("unroll") for (int m = 0; m < 4; ++m) _Pragma("unroll") for (int n = 0; n < 2; ++n) _Pragma("unroll") for (int k = 0; k < 2; ++k) \
        acc[ai][bj][m][n] = __builtin_amdgcn_mfma_f32_16x16x32_bf16(Bt[n][k], At[m][k], acc[ai][bj][m][n], 0, 0, 0); __builtin_amdgcn_s_setprio(0); } while (0)
#define PG8_WAIT_V(n) asm volatile("s_waitcnt vmcnt(" #n ")" ::: "memory")
#define PG8_WAIT_L(n) asm volatile("s_waitcnt lgkmcnt(" #n ")" ::: "memory")
#define PG8_BAR __builtin_amdgcn_s_barrier()
#define PG8_SCHED __builtin_amdgcn_sched_barrier(0)
    Unit cur, nxt; int ui = 0;
    if (!S.next(0, cur)) return;
    f32x4 acc[2][2][4][2];
#pragma unroll
    for (int a = 0; a < 2; ++a)
#pragma unroll
        for (int b = 0; b < 2; ++b)
#pragma unroll
            for (int m = 0; m < 4; ++m)
#pragma unroll
                for (int n = 0; n < 2; ++n) acc[a][b][m][n] = (f32x4){0.f, 0.f, 0.f, 0.f};
    bf16x8 At[4][2], B0[2][2], B1[2][2];
    const char* cA = (const char*)g.A + (size_t)cur.pm * tstepA; const char* cB = (const char*)g.Bt + (size_t)cur.pn * tstepB;
    PG8_STAGE(PG8_SB(0, 0), cB, voffB); PG8_STAGE(PG8_SB(0, 1), cB + hstepB, voffB); PG8_STAGE(PG8_SA(0, 0), cA, voffA); PG8_STAGE(PG8_SA(0, 1), cA + hstepA, voffA);
    if (wr == 1) PG8_BAR;
    PG8_WAIT_V(2); PG8_BAR;
    PG8_STAGE(PG8_SB(1, 0), cB + kstep, voffB); PG8_STAGE(PG8_SA(1, 0), cA + KOFFA(1), voffA); PG8_STAGE(PG8_SB(1, 1), cB + hstepB + kstep, voffB);
    PG8_WAIT_V(6); PG8_BAR;
    for (;;) {
        const bool has_next = S.next(ui + 1, nxt);
        const char* nA = has_next ? (const char*)g.A + (size_t)nxt.pm * tstepA : cA; const char* nB = has_next ? (const char*)g.Bt + (size_t)nxt.pn * tstepB : cB;
#pragma unroll 1
        for (int t = 0; t < nt; t += 2) {
            const bool last = (t == nt - 2);
            const char* a1 = cA + KOFFA(t + 1);
            const char* a2 = last ? nA : cA + KOFFA(t + 2); const char* b2 = last ? nB : cB + (size_t)(t + 2) * kstep;
            const char* a3 = last ? nA + KOFFA(1) : cA + KOFFA(t + 3); const char* b3 = b2 + kstep;
            PG8_LDB(B0, 0, 0); PG8_LDB(B1, 0, 1); PG8_SCHED; PG8_LDA(At, 0, 0); PG8_STAGE(PG8_SA(1, 1), a1 + hstepA, voffA);
            PG8_WAIT_V(8); PG8_WAIT_L(0); PG8_BAR; PG8_MMA(0, 0, At, B0); PG8_MMA(0, 1, At, B1); PG8_BAR; PG8_SCHED;
            PG8_LDA(At, 0, 1); PG8_STAGE(PG8_SB(0, 0), b2, voffB); PG8_STAGE(PG8_SB(0, 1), b2 + hstepB, voffB); PG8_STAGE(PG8_SA(0, 0), a2, voffA);
            PG8_WAIT_V(8); PG8_WAIT_L(0); PG8_BAR; PG8_MMA(1, 0, At, B0); PG8_MMA(1, 1, At, B1); PG8_BAR; PG8_SCHED;
            PG8_LDB(B0, 1, 0); PG8_LDB(B1, 1, 1); PG8_SCHED; PG8_LDA(At, 1, 0); PG8_STAGE(PG8_SA(0, 1), a2 + hstepA, voffA);
            PG8_WAIT_V(8); PG8_WAIT_L(0); PG8_BAR; PG8_MMA(0, 0, At, B0); PG8_MMA(0, 1, At, B1); PG8_BAR; PG8_SCHED;
            PG8_LDA(At, 1, 1); PG8_STAGE(PG8_SB(1, 0), b3, voffB); PG8_STAGE(PG8_SB(1, 1), b3 + hstepB, voffB); PG8_STAGE(PG8_SA(1, 0), a3, voffA);
            PG8_WAIT_V(8); PG8_WAIT_L(0); PG8_BAR; PG8_MMA(1, 0, At, B0); PG8_MMA(1, 1, At, B1); PG8_BAR; PG8_SCHED;
        }
        if (wr == 0) PG8_BAR;
        E(acc, cur, wr, wc, fr, fq);
        if (!has_next) break;
#pragma unroll
        for (int a = 0; a < 2; ++a)
#pragma unroll
            for (int b = 0; b < 2; ++b)
#pragma unroll
                for (int m = 0; m < 4; ++m)
#pragma unroll
                    for (int n = 0; n < 2; ++n) acc[a][b][m][n] = (f32x4){0.f, 0.f, 0.f, 0.f};
        cur = nxt; cA = nA; cB = nB; ++ui;
        if (wr == 1) PG8_BAR;
    }
    PG8_WAIT_V(0);
    PG8_BAR;
#undef KOFFA
#undef PG8_SA
#undef PG8_SB
#undef PG8_STAGE
#undef PG8_LDA
#undef PG8_LDB
#undef PG8_MMA
#undef PG8_WAIT_V
#undef PG8_WAIT_L
#undef PG8_BAR
#undef PG8_SCHED
}
typedef f32x4 Acc[2][2][4][2];

struct EpiGU {
    const float* ssq; bf16_t* H;
    __device__ __forceinline__ void operator()(const Acc& acc, const Unit& u, int wr, int wc, int fr, int fq) const {
#pragma unroll
        for (int ai = 0; ai < 2; ++ai)
#pragma unroll
            for (int m = 0; m < 4; ++m) {
                const int row = u.pm * BM + ai * HALF + wr * 64 + m * 16 + fr;
                const float rs = rsqrtf(sum16(ssq + (size_t)row * 16) * (1.0f / DM) + NEPS);
                float hv[8];
#pragma unroll
                for (int n = 0; n < 2; ++n)
#pragma unroll
                    for (int j = 0; j < 4; ++j) { const float gv = acc[ai][0][m][n][j] * rs, uv = acc[ai][1][m][n][j] * rs; hv[4 * n + j] = gv * sigmoidf_(gv) * uv; }
                *(u32x4*)(H + (size_t)row * FF + u.pn * HALF + wc * 32 + fq * 8) = pk8(hv);
            }
    }
};
struct EpiRes {
    const float* xin; float* xout; bf16_t* xb; float* ssq_next; float alpha; int dry;
    __device__ __forceinline__ void operator()(const Acc& acc, const Unit& u, int wr, int wc, int fr, int fq) const {
#pragma unroll
        for (int ai = 0; ai < 2; ++ai)
#pragma unroll
            for (int m = 0; m < 4; ++m) {
                const int row = u.pm * BM + ai * HALF + wr * 64 + m * 16 + fr;
                float sq = 0.f;
#pragma unroll
                for (int bj = 0; bj < 2; ++bj) {
                    const size_t off = (size_t)row * DM + u.pn * BM + bj * HALF + wc * 32 + fq * 8;
                    f32x4 x0 = *(const f32x4*)(xin + off), x1 = *(const f32x4*)(xin + off + 4);
                    x0 += alpha * acc[ai][bj][m][0]; x1 += alpha * acc[ai][bj][m][1];
                    if (dry <= 0) { *(f32x4*)(xout + off) = x0; *(f32x4*)(xout + off + 4) = x1; }
                    float v[8] = {x0[0], x0[1], x0[2], x0[3], x1[0], x1[1], x1[2], x1[3]};
                    if (dry >= 0) *(u32x4*)(xb + off) = pk8(v);
#pragma unroll
                    for (int j = 0; j < 8; ++j) sq += v[j] * v[j];
                }
                sq += __shfl_xor(sq, 16); sq += __shfl_xor(sq, 32);
                if (fq == 0) ssq_next[(size_t)row * 16 + u.pn * 4 + wc] = sq;
            }
    }
};
struct EpiWin {
    const float* ssq; const int* pos; bf16_t* U; float* ssq_q; float* ssq_kv; bf16_t* KR; bf16_t* VTR;
    __device__ __forceinline__ void operator()(const Acc& acc, const Unit& u, int wr, int wc, int fr, int fq) const {
#pragma unroll
        for (int bj = 0; bj < 2; ++bj) {
            const int hf = 2 * u.pn + bj;
            int mode = 0;
            if (hf == 12 || hf == 13 || hf == 16 || hf == 17) mode = 1; else if (hf == 18 || hf == 19) mode = 2; else if (hf >= 20 && hf <= 22) mode = 3;
            else if (hf == 23) mode = 4; else if (hf == 24) mode = 5; else if (hf == 26) mode = 6; else if (hf == 27) mode = 7;
            float inv[4];
#pragma unroll
            for (int q = 0; q < 4; ++q) { const int n = q >> 1, pp = q & 1;
                inv[q] = (mode == 7) ? exp2f(-(float)(4 * fq + 2 * n + pp) * (13.287712379549449f / 16.0f)) : exp2f(-(float)(16 * (wc & 1) + 4 * fq + 2 * n + pp) * (13.287712379549449f / 32.0f)); }
#pragma unroll
            for (int ai = 0; ai < 2; ++ai)
#pragma unroll
                for (int m = 0; m < 4; ++m) {
                    const int row = u.pm * BM + ai * HALF + wr * 64 + m * 16 + fr;
                    const float rs = rsqrtf(sum16(ssq + (size_t)row * 16) * (1.0f / DM) + NEPS);
                    float v[8];
#pragma unroll
                    for (int n = 0; n < 2; ++n)
#pragma unroll
                        for (int j = 0; j < 4; ++j) v[4 * n + j] = acc[ai][bj][m][n][j] * rs;
                    if (mode == 1 || mode == 7) {
                        const int p = pos[row];
#pragma unroll
                        for (int q = 0; q < 4; ++q) { float c, s; rope_cs(p, inv[q], c, s); const float x1 = v[2 * q], x2 = v[2 * q + 1]; v[2 * q] = x1 * c - x2 * s; v[2 * q + 1] = x1 * s + x2 * c; }
                    } else if (mode == 5) {
#pragma unroll
                        for (int j = 0; j < 8; ++j) { const float e = __expf(2.0f * v[j]); v[j] = 1.0f - 2.0f * __builtin_amdgcn_rcpf(e + 1.0f); }
                    } else if (mode == 6) {
#pragma unroll
                        for (int j = 0; j < 8; ++j) v[j] = sigmoidf_(v[j]);
                    }
                    if (mode == 2) {
                        const int b = row >> 11, t = row & 2047, h = 2 * (hf - 18) + (wc >> 1), dv0 = 32 * (wc & 1) + 8 * fq;
                        bf16_t* vt = VTR + ((size_t)((b * 4 + h) * 64 + dv0)) * SEQ + t;
#pragma unroll
                        for (int j = 0; j < 8; ++j) vt[(size_t)j * SEQ] = (bf16_t)f2bf(v[j]);
                    } else if (mode == 7) {
                        if (wc == 0) *(u32x4*)(KR + (size_t)row * 32 + fq * 8) = pk8(v);
                    } else {
                        *(u32x4*)(U + (size_t)row * NU + hf * HALF + wc * 32 + fq * 8) = pk8(v);
                        if (mode == 3 || mode == 4) {
                            float sq = 0.f;
#pragma unroll
                            for (int j = 0; j < 8; ++j) sq += v[j] * v[j];
                            sq += __shfl_xor(sq, 16); sq += __shfl_xor(sq, 32);
                            if (fq == 0) { if (mode == 3) ssq_q[(size_t)row * 16 + (hf - 20) * 4 + wc] = sq; else ssq_kv[(size_t)row * 4 + wc] = sq; }
                        }
                    }
                    __builtin_amdgcn_sched_barrier(0);
                }
        }
    }
};
struct EpiLora {
    unsigned char* ws; const float* b0; const float* b1; const float* b2; const float* b3;
    __device__ __forceinline__ void operator()(const Acc& acc, const Unit& u, int wr, int wc, int fr, int fq) const {
        const int comp = u.pn;
        bf16_t* D = (bf16_t*)(ws + (comp < 3 ? WS_EF + (size_t)comp * 8 * MiB : WS_AB + (size_t)(comp - 3) * 8 * MiB));
        const float* B = comp == 0 ? b0 : comp == 1 ? b1 : comp == 2 ? b2 : b3;
        const float c0 = comp < 2 ? 0.6065306597126334f : 1.0f;
        const bool act = comp < 4;
#pragma unroll
        for (int bj = 0; bj < 2; ++bj) {
            const int ch = bj * HALF + wc * 32 + fq * 8;
            f32x4 bb0 = {0.f, 0.f, 0.f, 0.f}, bb1 = {0.f, 0.f, 0.f, 0.f};
            if (act) { bb0 = *(const f32x4*)(B + ch); bb1 = *(const f32x4*)(B + ch + 4); }
#pragma unroll
            for (int ai = 0; ai < 2; ++ai)
#pragma unroll
                for (int m = 0; m < 4; ++m) {
                    const int row = u.pm * BM + ai * HALF + wr * 64 + m * 16 + fr;
                    const f32x4 x0 = acc[ai][bj][m][0] + bb0, x1 = acc[ai][bj][m][1] + bb1;
                    float v[8] = {x0[0], x0[1], x0[2], x0[3], x1[0], x1[1], x1[2], x1[3]};
                    if (act) {
#pragma unroll
                        for (int j = 0; j < 8; ++j) v[j] = c0 * sigmoidf_(v[j]);
                    }
                    *(u32x4*)(D + (size_t)row * 256 + ch) = pk8(v);
                }
        }
    }
};
struct EpiMla {
    const float* ssq_q; const float* ssq_kv; const int* pos; bf16_t* QM; bf16_t* KN; bf16_t* VTM;
    __device__ __forceinline__ void operator()(const Acc& acc, const Unit& u, int wr, int wc, int fr, int fq) const {
        float inv[4];
#pragma unroll
        for (int q = 0; q < 4; ++q) inv[q] = exp2f(-(float)(4 * fq + q) * (13.287712379549449f / 16.0f));
#pragma unroll
        for (int bj = 0; bj < 2; ++bj) {
            const int n0 = u.pn * BM + bj * HALF + wc * 32;
            if (n0 >= 896) continue;
            const bool isq = n0 < 384;
            const bool isrope = isq && ((n0 >> 5) % 3 == 2);
            const int nn = n0 - 384, hh = nn >> 7, c0 = nn & 127;
#pragma unroll
            for (int ai = 0; ai < 2; ++ai)
#pragma unroll
                for (int m = 0; m < 4; ++m) {
                    const int row = u.pm * BM + ai * HALF + wr * 64 + m * 16 + fr;
                    const float rs = isq ? rsqrtf(sum12(ssq_q + (size_t)row * 16) * (1.0f / 384.0f) + NEPS) : rsqrtf(sum4(ssq_kv + (size_t)row * 4) * (1.0f / 128.0f) + NEPS);
                    float v[8];
#pragma unroll
                    for (int n = 0; n < 2; ++n)
#pragma unroll
                        for (int j = 0; j < 4; ++j) v[4 * n + j] = acc[ai][bj][m][n][j] * rs;
                    if (isq) {
                        if (isrope) { const int p = pos[row];
#pragma unroll
                            for (int q = 0; q < 4; ++q) { float c, s; rope_cs(p, inv[q], c, s); const float x1 = v[2 * q], x2 = v[2 * q + 1]; v[2 * q] = x1 * c - x2 * s; v[2 * q + 1] = x1 * s + x2 * c; } }
                        *(u32x4*)(QM + (size_t)row * 384 + n0 + fq * 8) = pk8(v);
                    } else if (c0 < 64) {
                        *(u32x4*)(KN + (size_t)row * 256 + hh * 64 + c0 + fq * 8) = pk8(v);
                    } else {
                        const int b = row >> 11, t = row & 2047, dv0 = c0 - 64 + 8 * fq;
                        bf16_t* vt = VTM + ((size_t)((b * 4 + hh) * 64 + dv0)) * SEQ + t;
#pragma unroll
                        for (int j = 0; j < 8; ++j) vt[(size_t)j * SEQ] = (bf16_t)f2bf(v[j]);
                    }
                    __builtin_amdgcn_sched_barrier(0);
                }
        }
    }
};
}

template <int MODE>
__device__ __forceinline__ void attn_unit(LAS unsigned char* lds, unsigned char* ws, const float* gn_g, int unit, const int tid, const int ocol = U_TG) {
    constexpr int DQK = MODE == 0 ? 96 : 64, NS = DQK / 16, KS = (DQK + 8) * 2, VS = 136, KBUF = 64 * KS, VBUF = 64 * VS, CPR = DQK / 8, NKC = 64 * CPR;
    const int wid = tid >> 6, lane = tid & 63, ql = lane & 31, hi = lane >> 5;
    const int b = unit >> 5, h = (unit >> 3) & 3, qb = unit & 7;
    const int tok0 = b * SEQ, qi = qb * 256 + wid * 32 + ql;
    bf16_t* U = (bf16_t*)(ws + WS_U);
    const bf16_t* QM = (const bf16_t*)(ws + WS_QM); const bf16_t* KN = (const bf16_t*)(ws + WS_KN); const bf16_t* KR = (const bf16_t*)(ws + WS_KR);
    const bf16_t* VT = (const bf16_t*)(ws + (MODE == 0 ? WS_VTM : WS_VTR)) + (size_t)((b * 4 + h) * 64) * SEQ;
    bf16x8 qf[NS];
    { const bf16_t* qrow = MODE == 0 ? QM + (size_t)(tok0 + qi) * 384 + h * 96 : U + (size_t)(tok0 + qi) * NU + U_TQ + h * 64;
#pragma unroll
      for (int s = 0; s < NS; ++s) qf[s] = *(const bf16x8*)(qrow + 16 * s + 8 * hi); }
    const int kc0 = tid, kc1 = tid + 512;
    const int vdv = tid >> 3, vcc = tid & 7;
    u32x4 kreg0, kreg1 = {0, 0, 0, 0}, vreg;
    auto kaddr = [&](int c, int j0) -> const bf16_t* {
        const int key = c / CPR, cc = c % CPR; const size_t tok = (size_t)(tok0 + j0 + key);
        if (MODE == 0) return cc < 8 ? KN + tok * 256 + h * 64 + cc * 8 : KR + tok * 32 + (cc - 8) * 8;
        return U + tok * NU + U_TK + h * 64 + cc * 8;
    };
    auto gload = [&](int j0) {
        kreg0 = *(const u32x4*)kaddr(kc0, j0);
        if (kc1 < NKC) kreg1 = *(const u32x4*)kaddr(kc1, j0);
        vreg = *(const u32x4*)(VT + (size_t)vdv * SEQ + j0 + vcc * 8);
    };
    auto lwrite = [&](int buf) {
        LAS unsigned char* kb = lds + buf * KBUF; LAS unsigned char* vb = lds + 2 * KBUF + buf * VBUF;
        *(LAS u32x4*)(kb + (kc0 / CPR) * KS + (kc0 % CPR) * 16) = kreg0;
        if (kc1 < NKC) *(LAS u32x4*)(kb + (kc1 / CPR) * KS + (kc1 % CPR) * 16) = kreg1;
        *(LAS u32x2*)(vb + vdv * VS + vcc * 16) = (u32x2){vreg.x, vreg.y};
        *(LAS u32x2*)(vb + vdv * VS + vcc * 16 + 8) = (u32x2){vreg.z, vreg.w};
    };
    f32x16 ot[2];
#pragma unroll
    for (int i = 0; i < 16; ++i) { ot[0][i] = 0.f; ot[1][i] = 0.f; }
    float mrun = -1e30f, lrun = 0.f;
    const float lgam = MODE == 1 ? log2f(1.0f - exp2f(-5.0f - (float)h)) : 0.f;
    __syncthreads();
    gload(0); lwrite(0);
    __syncthreads();
    constexpr int NT = SEQ / 64;
    for (int t = 0; t < NT; ++t) {
        const int buf = t & 1;
        if (t + 1 < NT) gload((t + 1) * 64);
        LAS unsigned char* kb = lds + buf * KBUF; LAS unsigned char* vb = lds + 2 * KBUF + buf * VBUF;
        f32x16 st[2];
#pragma unroll
        for (int i = 0; i < 16; ++i) { st[0][i] = 0.f; st[1][i] = 0.f; }
        {
            bf16x8 kfr[2][NS];
#pragma unroll
            for (int kt2 = 0; kt2 < 2; ++kt2)
#pragma unroll
                for (int s = 0; s < NS; ++s) kfr[kt2][s] = *(const LAS bf16x8*)(kb + (32 * kt2 + ql) * KS + (16 * s + 8 * hi) * 2);
            __builtin_amdgcn_sched_barrier(0);
#pragma unroll
            for (int s = 0; s < NS; ++s)
#pragma unroll
                for (int kt2 = 0; kt2 < 2; ++kt2) st[kt2] = __builtin_amdgcn_mfma_f32_32x32x16_bf16(kfr[kt2][s], qf[s], st[kt2], 0, 0, 0);
        }
        u32x4 vfr[2][2][2];
#pragma unroll
        for (int kt2 = 0; kt2 < 2; ++kt2)
#pragma unroll
            for (int s2 = 0; s2 < 2; ++s2)
#pragma unroll
                for (int dt = 0; dt < 2; ++dt) {
                    LAS unsigned char* vp = vb + (32 * dt + ql) * VS + (32 * kt2 + 16 * s2 + 4 * hi) * 2;
                    const u32x2 v0 = *(const LAS u32x2*)vp, v1 = *(const LAS u32x2*)(vp + 16);
                    vfr[kt2][s2][dt] = (u32x4){v0.x, v0.y, v1.x, v1.y};
                }
        __builtin_amdgcn_sched_barrier(0);
        if (MODE == 0) {
            float mx = st[0][0];
#pragma unroll
            for (int i = 0; i < 16; ++i) { mx = fmaxf(mx, st[0][i]); mx = fmaxf(mx, st[1][i]); }
            mx = fmaxf(mx, __shfl_xor(mx, 32));
            const float mnew = fmaxf(mrun, mx), alpha = __builtin_amdgcn_exp2f(mrun - mnew);
            mrun = mnew; float ls = 0.f;
#pragma unroll
            for (int i = 0; i < 16; ++i) { st[0][i] = __builtin_amdgcn_exp2f(st[0][i] - mnew); st[1][i] = __builtin_amdgcn_exp2f(st[1][i] - mnew); ls += st[0][i] + st[1][i]; }
            lrun = lrun * alpha + ls;
            if (__builtin_amdgcn_ballot_w64(alpha != 1.0f)) {
#pragma unroll
                for (int i = 0; i < 16; ++i) { ot[0][i] *= alpha; ot[1][i] *= alpha; }
            }
        } else {
            const float dq = (float)(qi - (t * 64 + 4 * hi));
#pragma unroll
            for (int kt2 = 0; kt2 < 2; ++kt2)
#pragma unroll
                for (int i = 0; i < 16; ++i) { const float d = fabsf(dq - (float)(32 * kt2 + 8 * (i >> 2) + (i & 3))); st[kt2][i] *= __builtin_amdgcn_exp2f(lgam * d); }
        }
        {
#pragma unroll
            for (int kt2 = 0; kt2 < 2; ++kt2)
#pragma unroll
                for (int s2 = 0; s2 < 2; ++s2) {
                    u32x4 pw; pw.x = pk2(st[kt2][8 * s2 + 0], st[kt2][8 * s2 + 1]); pw.y = pk2(st[kt2][8 * s2 + 2], st[kt2][8 * s2 + 3]);
                    pw.z = pk2(st[kt2][8 * s2 + 4], st[kt2][8 * s2 + 5]); pw.w = pk2(st[kt2][8 * s2 + 6], st[kt2][8 * s2 + 7]);
                    const bf16x8 pf = __builtin_bit_cast(bf16x8, pw);
#pragma unroll
                    for (int dt = 0; dt < 2; ++dt) ot[dt] = __builtin_amdgcn_mfma_f32_32x32x16_bf16(__builtin_bit_cast(bf16x8, vfr[kt2][s2][dt]), pf, ot[dt], 0, 0, 0);
                }
        }
        if (t + 1 < NT) lwrite(buf ^ 1);
        __syncthreads();
    }
    const size_t orow = (size_t)(tok0 + qi) * NU;
    if (MODE == 0) {
        const float ltot = lrun + __shfl_xor(lrun, 32), il = 1.0f / ltot;
#pragma unroll
        for (int dt = 0; dt < 2; ++dt)
#pragma unroll
            for (int g = 0; g < 4; ++g) {
                u32x2 w; w.x = pk2(ot[dt][4 * g] * il, ot[dt][4 * g + 1] * il); w.y = pk2(ot[dt][4 * g + 2] * il, ot[dt][4 * g + 3] * il);
                *(u32x2*)(U + orow + U_QA + h * 64 + 32 * dt + 8 * g + 4 * hi) = w;
            }
    } else {
        float sq = 0.f;
#pragma unroll
        for (int i = 0; i < 16; ++i) sq += ot[0][i] * ot[0][i] + ot[1][i] * ot[1][i];
        sq += __shfl_xor(sq, 32);
        const float rs = rsqrtf(sq * (1.0f / 64.0f) + NEPS);
#pragma unroll
        for (int dt = 0; dt < 2; ++dt)
#pragma unroll
            for (int g = 0; g < 4; ++g) {
                const int dv = 32 * dt + 8 * g + 4 * hi;
                bf16_t* gp = U + orow + U_TG + h * 64 + dv;
                const u32x2 gw = *(const u32x2*)gp;
                const float g0 = bflo(gw.x), g1 = bfhi(gw.x), g2 = bflo(gw.y), g3 = bfhi(gw.y);
                const f32x4 gg = *(const f32x4*)(gn_g + h * 64 + dv);
                const float o0 = ot[dt][4 * g] * rs * gg[0] * g0 * sigmoidf_(g0), o1 = ot[dt][4 * g + 1] * rs * gg[1] * g1 * sigmoidf_(g1);
                const float o2 = ot[dt][4 * g + 2] * rs * gg[2] * g2 * sigmoidf_(g2), o3 = ot[dt][4 * g + 3] * rs * gg[3] * g3 * sigmoidf_(g3);
                u32x2 w; w.x = pk2(o0, o1); w.y = pk2(o2, o3);
                *(u32x2*)(U + orow + ocol + h * 64 + dv) = w;
            }
    }
}

struct ScOp { f32x4 w4, kk, nb, kd, r4; float v1; };
#define SC_LD(x, s) do { asm volatile("ds_read_b128 %0, %1 offset:%2" : "=v"(x.w4) : "v"(ao), "n"((s) * 1280)); asm volatile("ds_read_b128 %0, %1 offset:%2" : "=v"(x.kk) : "v"(ao), "n"((s) * 1280 + 256)); \
        asm volatile("ds_read_b128 %0, %1 offset:%2" : "=v"(x.nb) : "v"(ao), "n"((s) * 1280 + 512)); asm volatile("ds_read_b128 %0, %1 offset:%2" : "=v"(x.kd) : "v"(ao), "n"((s) * 1280 + 768)); \
        asm volatile("ds_read_b128 %0, %1 offset:%2" : "=v"(x.r4) : "v"(ao), "n"((s) * 1280 + 1024)); asm volatile("ds_read_b32 %0, %1 offset:%2" : "=v"(x.v1) : "v"(av), "n"((s) * 128)); } while (0)
#define SC_WAIT(x, n) asm volatile("s_waitcnt lgkmcnt(" #n ")" : "+v"(x.w4), "+v"(x.kk), "+v"(x.nb), "+v"(x.kd), "+v"(x.r4), "+v"(x.v1) :: "memory")
#define SC_SA(x) float sa = __builtin_fmaf(p[3], x.kk[3], __builtin_fmaf(p[2], x.kk[2], __builtin_fmaf(p[1], x.kk[1], p[0] * x.kk[0]))); \
        sa += dppf<0xB1>(sa); sa += dppf<0x4E>(sa); sa += dppf<0x124>(sa); sa += dppf<0x128>(sa);
#define SC_UPDY(x, yv) do { p[0] = __builtin_fmaf(sa, x.nb[0], __builtin_fmaf(p[0], x.w4[0], x.v1 * x.kd[0])); p[1] = __builtin_fmaf(sa, x.nb[1], __builtin_fmaf(p[1], x.w4[1], x.v1 * x.kd[1])); \
        p[2] = __builtin_fmaf(sa, x.nb[2], __builtin_fmaf(p[2], x.w4[2], x.v1 * x.kd[2])); p[3] = __builtin_fmaf(sa, x.nb[3], __builtin_fmaf(p[3], x.w4[3], x.v1 * x.kd[3])); \
        yv = __builtin_fmaf(p[3], x.r4[3], __builtin_fmaf(p[2], x.r4[2], __builtin_fmaf(p[1], x.r4[1], p[0] * x.r4[0]))); } while (0)
#define SC_STEPY(cur, nxt, s, yv) do { SC_LD(nxt, (s) + 1); SC_WAIT(cur, 6); { SC_SA(cur); SC_UPDY(cur, yv); } } while (0)
#define SC_YRED(g) do { const float k01 = b0 ? y1 : y0, s01 = b0 ? y0 : y1, k23 = b0 ? y3 : y2, s23 = b0 ? y2 : y3; \
        const float a0 = k01 + dppf<0xB1>(s01), a1 = k23 + dppf<0xB1>(s23); const float k2 = b1 ? a1 : a0, s2 = b1 ? a0 : a1; \
        float bs = k2 + dppf<0x4E>(s2); bs += dppf<0x124>(bs); bs += dppf<0x128>(bs); *(LAS float*)(yo4 + (g) * 512) = bs; } while (0)
#define SC_GROUP(s) do { SC_STEPY(ca, cb, s, y0); SC_STEPY(cb, ca, (s) + 1, y1); SC_STEPY(ca, cb, (s) + 2, y2); SC_STEPY(cb, ca, (s) + 3, y3); SC_YRED((s) / 4); } while (0)
__device__ __forceinline__ void rwkv_scan(LAS unsigned char* lds, unsigned char* ws, const float* k_k, const float* k_a, int sidx, const int tid) {
    constexpr int TC = 32, OPB = TC * 5 * 64 * 4, VVB = TC * 32 * 4, YOB = TC * 32 * 4;
    const int wid = tid >> 6, lane = tid & 63;
    const int scan = sidx >> 1, hb = sidx & 1, b = scan >> 3, h = (scan >> 1) & 3, dir = scan & 1;
    const bf16_t* U = (const bf16_t*)(ws + WS_U);
    const bf16_t* E = (const bf16_t*)(ws + (dir ? WS_EB : WS_EF)); const bf16_t* A = (const bf16_t*)(ws + (dir ? WS_AB : WS_AF));
    bf16_t* Y = (bf16_t*)(ws + (dir ? WS_YB : WS_YF));
    LAS unsigned char* ops = lds; LAS unsigned char* vvb = lds + 2 * OPB; LAS unsigned char* yob = lds + 2 * OPB + 2 * VVB;
    const int ts = tid >> 4, cj = tid & 15, ch = h * 64 + 4 * cj;
    const f32x4 kk_w = *(const f32x4*)(k_k + ch), ka_w = *(const f32x4*)(k_a + ch);
    struct G { u32x2 rk, rr, rv, re, ra; };
    auto gload = [&](int c) -> G {
        G g;
        const int sI = c * TC + ts, t = dir ? (SEQ - 1 - sI) : sI; const size_t row = (size_t)(b * SEQ + t);
        g.rk = *(const u32x2*)(U + row * NU + U_RK + ch); g.rr = *(const u32x2*)(U + row * NU + U_RR + ch); g.rv = *(const u32x2*)(U + row * NU + U_RV + ch);
        g.re = *(const u32x2*)(E + row * 256 + ch); g.ra = *(const u32x2*)(A + row * 256 + ch);
        return g;
    };
    auto lwrite = [&](int buf, const G& g) {
        const u32x2 rk = g.rk, rr = g.rr, rv = g.rv, re = g.re, ra = g.ra;
        const f32x4 k4 = {bflo(rk.x), bfhi(rk.x), bflo(rk.y), bfhi(rk.y)}, r4 = {bflo(rr.x), bfhi(rr.x), bflo(rr.y), bfhi(rr.y)}, v4 = {bflo(rv.x), bfhi(rv.x), bflo(rv.y), bfhi(rv.y)};
        const f32x4 e4 = {bflo(re.x), bfhi(re.x), bflo(re.y), bfhi(re.y)}, a4 = {bflo(ra.x), bfhi(ra.x), bflo(ra.y), bfhi(ra.y)};
        f32x4 kk = k4 * kk_w;
        float ss = kk[0] * kk[0] + kk[1] * kk[1] + kk[2] * kk[2] + kk[3] * kk[3];
        ss = rowsum16(ss);
        const float nrm = __builtin_amdgcn_rcpf(fmaxf(__builtin_amdgcn_sqrtf(ss), 1e-12f));
        kk = kk * nrm;
        const f32x4 nb = -(kk * a4);
        f32x4 w4; w4[0] = __expf(-e4[0]); w4[1] = __expf(-e4[1]); w4[2] = __expf(-e4[2]); w4[3] = __expf(-e4[3]);
        const f32x4 kd = k4 * (1.0f + (a4 - 1.0f) * ka_w);
        LAS unsigned char* o = ops + buf * OPB + ts * 1280 + cj * 16;
        *(LAS f32x4*)(o) = w4; *(LAS f32x4*)(o + 256) = kk; *(LAS f32x4*)(o + 512) = nb; *(LAS f32x4*)(o + 768) = kd; *(LAS f32x4*)(o + 1024) = r4;
        if ((cj >> 3) == hb) *(LAS f32x4*)(vvb + buf * VVB + ts * 128 + (cj & 7) * 16) = v4;
    };
    auto flush = [&](int c) {
#pragma unroll
        for (int i = 0; i < 2; ++i) {
            const int idx = tid + i * 512, s = idx >> 5, ri = idx & 31;
            const int sI = c * TC + s, t = dir ? (SEQ - 1 - sI) : sI;
            const float yv = *(const LAS float*)(yob + (c & 1) * YOB + s * 128 + ri * 4);
            Y[(size_t)(b * SEQ + t) * 256 + h * 64 + 32 * hb + ri] = (bf16_t)f2bf(yv);
        }
    };
    f32x4 p = {0.f, 0.f, 0.f, 0.f};
    const int rr4 = lane >> 4, lc = lane & 15, rowA = 4 * wid + rr4;
    const bool b0 = (lane & 1) != 0, b1 = (lane & 2) != 0;
    auto compute = [&](int buf) {
        const unsigned ao = (unsigned)(unsigned long long)(ops + buf * OPB + lc * 16), av = (unsigned)(unsigned long long)(vvb + buf * VVB + rowA * 4);
        LAS unsigned char* yo4 = yob + buf * YOB + (lane & 3) * 128 + rowA * 4;
        ScOp ca, cb; float y0, y1, y2, y3;
        SC_LD(ca, 0);
        SC_GROUP(0); SC_GROUP(4); SC_GROUP(8); SC_GROUP(12); SC_GROUP(16); SC_GROUP(20); SC_GROUP(24);
        SC_STEPY(ca, cb, 28, y0); SC_STEPY(cb, ca, 29, y1); SC_STEPY(ca, cb, 30, y2);
        SC_WAIT(cb, 0); { SC_SA(cb); SC_UPDY(cb, y3); } SC_YRED(7);
    };
    constexpr int NC = SEQ / TC;
    G g0, g1;
    __syncthreads();
    { const G t0 = gload(0); lwrite(0, t0); g0 = gload(1); g1 = gload(2); }
    __syncthreads();
    for (int c = 0; c < NC; c += 2) {
        compute(0); lwrite(1, g0); if (c + 3 < NC) g0 = gload(c + 3);
        __syncthreads();
        flush(c);
        compute(1); if (c + 2 < NC) { lwrite(0, g1); if (c + 4 < NC) g1 = gload(c + 4); }
        __syncthreads();
        flush(c + 1);
    }
    __syncthreads();
}

__device__ __forceinline__ const void* ldptr(volatile LAS unsigned long long* t, int i);
template <class F> __device__ __forceinline__ void conv_mat(bf16_t* dst, int N, int K, F f, long gtid, long gthreads) {
    const unsigned nlines = (unsigned)N * (unsigned)(K >> 6);
    const unsigned li0 = (unsigned)(gtid >> 3), dli = (unsigned)(gthreads >> 3), sub = (unsigned)gtid & 7u;
    unsigned n = li0 % (unsigned)N, kl = li0 / (unsigned)N;
    const unsigned dn = dli % (unsigned)N, dk = dli / (unsigned)N;
    unsigned li = li0;
    for (; li + 3u * dli < nlines; li += 4u * dli) {
        unsigned nn[4], kk[4];
#pragma unroll
        for (int q = 0; q < 4; ++q) { nn[q] = n; kk[q] = kl; n += dn; kl += dk; if (n >= (unsigned)N) { n -= (unsigned)N; ++kl; } }
        float v0[8], v1[8], v2[8], v3[8];
        f((int)nn[0], (int)(sub + 8u * kk[0]) * 8, v0); f((int)nn[1], (int)(sub + 8u * kk[1]) * 8, v1);
        f((int)nn[2], (int)(sub + 8u * kk[2]) * 8, v2); f((int)nn[3], (int)(sub + 8u * kk[3]) * 8, v3);
        *(u32x4*)(dst + (size_t)nn[0] * K + (sub + 8u * kk[0]) * 8) = pk8(v0); *(u32x4*)(dst + (size_t)nn[1] * K + (sub + 8u * kk[1]) * 8) = pk8(v1);
        *(u32x4*)(dst + (size_t)nn[2] * K + (sub + 8u * kk[2]) * 8) = pk8(v2); *(u32x4*)(dst + (size_t)nn[3] * K + (sub + 8u * kk[3]) * 8) = pk8(v3);
    }
    for (; li < nlines; li += dli) {
        const int kc = (int)(sub + 8u * kl);
        float v[8];
        f((int)n, kc * 8, v);
        *(u32x4*)(dst + (size_t)n * K + kc * 8) = pk8(v);
        n += dn; kl += dk; if (n >= (unsigned)N) { n -= (unsigned)N; ++kl; }
    }
}
typedef const __attribute__((address_space(1))) float* gfp_t;
#define GLD(p, i) (((gfp_t)(p))[(i)])
__device__ __forceinline__ void convert_region_a(volatile LAS unsigned long long* ptab, int l, long gtid, long gth) {
    unsigned char* ws = (unsigned char*)ldptr(ptab, 35);
    {
        const float* wg = ((const float*)ldptr(ptab, 3)) + (size_t)l * DM * FF; const float* wu = ((const float*)ldptr(ptab, 4)) + (size_t)l * DM * FF; const float* nr = ((const float*)ldptr(ptab, 2)) + l * DM;
        conv_mat((bf16_t*)(ws + WS_WGU1), 2 * FF, DM, [=](int n, int k0, float* v) { const int pn = n >> 8, rr = n & 255; const float* src = (rr >> 7) ? wu : wg; const int j = pn * 128 + (rr & 127);
#pragma unroll
            for (int i = 0; i < 8; ++i) v[i] = GLD(src, (size_t)(k0 + i) * FF + j) * GLD(nr, k0 + i); }, gtid, gth);
    }
    {   const float* wd = ((const float*)ldptr(ptab, 5)) + (size_t)l * FF * DM;
        conv_mat((bf16_t*)(ws + WS_WD1), DM, FF, [=](int n, int k0, float* v) {
#pragma unroll
            for (int i = 0; i < 8; ++i) v[i] = GLD(wd, (size_t)(k0 + i) * DM + n); }, gtid, gth);
    }
    {
        const float* wi = ((const float*)ldptr(ptab, 7)) + (size_t)l * DM * INW; const float* nr = ((const float*)ldptr(ptab, 6)) + l * DM;
        conv_mat((bf16_t*)(ws + WS_WIN), NU, DM, [=](int n, int k0, float* v) {
            int s; float sc = 1.f;
            if (n < 768) s = n;
            else if (n < 1024) s = 1024 + (n - 768);
            else if (n < 1280) s = 768 + (n - 1024);
            else if (n < 1536) s = n;
            else if (n < 1792) { const int j = n - 1536, c = j & 63; s = 1920 + (j & ~63) + (c >> 1) + 32 * (c & 1); }
            else if (n < 2048) s = 2688 + (n - 1792);
            else if (n < 2304) { const int j = n - 2048, c = j & 63; s = 2176 + (j & ~63) + (c >> 1) + 32 * (c & 1); sc = 0.125f; }
            else if (n < 2560) s = 2432 + (n - 2304);
            else if (n < 2944) s = 2944 + (n - 2560);
            else if (n < 3072) s = 3328 + (n - 2944);
            else if (n < 3456) s = 1536 + (n - 3072);
            else if (n < 3488) { const int c = n - 3456; s = 3456 + (c >> 1) + 16 * (c & 1); }
            else { s = 0; sc = 0.f; }
#pragma unroll
            for (int i = 0; i < 8; ++i) v[i] = GLD(wi, (size_t)(k0 + i) * INW + s) * GLD(nr, k0 + i) * sc; }, gtid, gth);
    }
    {
        const float* w2f = ((const float*)ldptr(ptab, 12)) + l * 64 * 256; const float* w2b = ((const float*)ldptr(ptab, 13)) + l * 64 * 256; const float* a2f = ((const float*)ldptr(ptab, 16)) + l * 64 * 256; const float* a2b = ((const float*)ldptr(ptab, 17)) + l * 64 * 256; const float* g2 = ((const float*)ldptr(ptab, 18)) + l * 128 * 256;
        conv_mat((bf16_t*)(ws + WS_WLORA), 1280, 384, [=](int n, int k0, float* v) {
            const int comp = n >> 8, c = n & 255; const float* src = w2f; int kr = 0; float m = 0.f;
            if (comp == 0 && k0 < 64) { src = w2f; kr = k0; m = 1.f; } else if (comp == 1 && k0 >= 64 && k0 < 128) { src = w2b; kr = k0 - 64; m = 1.f; }
            else if (comp == 2 && k0 >= 128 && k0 < 192) { src = a2f; kr = k0 - 128; m = 1.f; } else if (comp == 3 && k0 >= 192 && k0 < 256) { src = a2b; kr = k0 - 192; m = 1.f; }
            else if (comp == 4 && k0 >= 256) { src = g2; kr = k0 - 256; m = 1.f; }
#pragma unroll
            for (int i = 0; i < 8; ++i) v[i] = GLD(src, (size_t)(kr + i) * 256 + c) * m; }, gtid, gth);
    }
    {
        const float* qb = ((const float*)ldptr(ptab, 26)) + (size_t)l * 384 * 384; const float* qn = ((const float*)ldptr(ptab, 25)) + l * 384; const float* kvb = ((const float*)ldptr(ptab, 28)) + (size_t)l * 128 * 512; const float* kvn = ((const float*)ldptr(ptab, 27)) + l * 128;
        const float qscale = 0.10206207261596577f * 1.4426950408889634f;
        conv_mat((bf16_t*)(ws + WS_WMLA), 1024, 512, [=](int n, int k0, float* v) {
            const float* wp = qb; const float* np = qn; int stride = 384, col = 0, kr = 0; float m = 0.f;
            if (n < 384 && k0 < 384) { const int hh = n / 96, c = n % 96; int sc = c; if (c >= 64) { const int cc = c - 64; sc = 64 + (cc >> 1) + 16 * (cc & 1); }
                col = hh * 96 + sc; kr = k0; m = qscale; }
            else if (n >= 384 && n < 896 && k0 >= 384) { wp = kvb; np = kvn; stride = 512; col = n - 384; kr = k0 - 384; m = 1.f; }
#pragma unroll
            for (int i = 0; i < 8; ++i) v[i] = GLD(wp, (size_t)(kr + i) * stride + col) * GLD(np, kr + i) * m; }, gtid, gth);
    }
}
__device__ __forceinline__ void convert_region_b(volatile LAS unsigned long long* ptab, int l, long gtid, long gth) {
    unsigned char* ws = (unsigned char*)ldptr(ptab, 35);
    {   const float* wo = ((const float*)ldptr(ptab, 8)) + (size_t)l * DM * DM;
        conv_mat((bf16_t*)(ws + WS_WOUT), DM, DM, [=](int n, int k0, float* v) {
#pragma unroll
            for (int i = 0; i < 8; ++i) v[i] = GLD(wo, (size_t)(k0 + i) * DM + n); }, gtid, gth);
    }
    {   const float* wg = ((const float*)ldptr(ptab, 30)) + (size_t)l * DM * FF; const float* wu = ((const float*)ldptr(ptab, 31)) + (size_t)l * DM * FF; const float* nr = ((const float*)ldptr(ptab, 29)) + l * DM;
        conv_mat((bf16_t*)(ws + WS_WGU2), 2 * FF, DM, [=](int n, int k0, float* v) { const int pn = n >> 8, rr = n & 255; const float* src = (rr >> 7) ? wu : wg; const int j = pn * 128 + (rr & 127);
#pragma unroll
            for (int i = 0; i < 8; ++i) v[i] = GLD(src, (size_t)(k0 + i) * FF + j) * GLD(nr, k0 + i); }, gtid, gth);
    }
    {   const float* wd = ((const float*)ldptr(ptab, 32)) + (size_t)l * FF * DM;
        conv_mat((bf16_t*)(ws + WS_WD2), DM, FF, [=](int n, int k0, float* v) {
#pragma unroll
            for (int i = 0; i < 8; ++i) v[i] = GLD(wd, (size_t)(k0 + i) * DM + n); }, gtid, gth);
    }
}


#define XB_TMO      128
#define XB_XCNT(j)  (256  + 64 * (j))
#define XB_XSUB(j)  (1280 + 64 * (j))
#define XB_XGEN(j)  (2304 + 64 * (j))
#define XB_TOP      3328
#define XB_TOPGEN   3392
#define XCD_BAR_WORDS 3456
#define XB_SPIN_CAP (1u << 22)
__device__ __forceinline__ unsigned xb_ld(unsigned* p)              { return __hip_atomic_load(p, __ATOMIC_RELAXED, __HIP_MEMORY_SCOPE_AGENT); }
__device__ __forceinline__ unsigned xb_add(unsigned* p, unsigned v) { return __hip_atomic_fetch_add(p, v, __ATOMIC_RELAXED, __HIP_MEMORY_SCOPE_AGENT); }
__device__ __forceinline__ unsigned xb_xcc_id() { return (unsigned)__builtin_amdgcn_s_getreg((3 << 11) | 20) & 0xFu; }
#define XB_SPIN(cond, bar) do { unsigned _sp = 0; while (cond) { __builtin_amdgcn_s_sleep(1); \
    if ((++_sp & 255u) == 0u) { if (xb_ld(&(bar)[XB_TMO])) break; if (_sp > XB_SPIN_CAP) { atomicAdd(&(bar)[XB_TMO], 1u); break; } } } } while (0)
struct XcdBarrier { unsigned* bar; unsigned x; volatile LAS unsigned* st; };
__device__ __forceinline__ XcdBarrier xcd_barrier_post(unsigned* bar, volatile LAS unsigned* st) {
    XcdBarrier b; b.bar = bar; b.x = xb_xcc_id(); b.st = st;
    if (threadIdx.x == 0) (void)xb_add(&bar[XB_XCNT(b.x)], 1u);
    return b;
}
__device__ __forceinline__ void xcd_barrier_complete(unsigned* bar, unsigned x, unsigned& nloc, unsigned& nx) {
    const unsigned G = gridDim.x * gridDim.y * gridDim.z;
    unsigned sum, cnt, mine, sp = 0u;
    for (;;) {
        sum = 0u; cnt = 0u; mine = 0u;
#pragma unroll
        for (unsigned j = 0; j < 16; ++j) { const unsigned c = xb_ld(&bar[XB_XCNT(j)]); sum += c; cnt += (c > 0u) ? 1u : 0u; mine = (j == x) ? c : mine; }
        if (sum == G) break;
        __builtin_amdgcn_s_sleep(1);
        if ((++sp & 255u) == 0u) { if (xb_ld(&bar[XB_TMO])) break; if (sp > XB_SPIN_CAP) { atomicAdd(&bar[XB_TMO], 1u); break; } }
    }
    nloc = mine > 0u ? mine : 1u; nx = cnt > 0u ? cnt : 1u;
}
__device__ __forceinline__ void xcd_barrier(const XcdBarrier& b) {
    asm volatile("s_waitcnt vmcnt(0)" ::: "memory");
    __syncthreads();
    if (threadIdx.x == 0) {
        unsigned* bar = b.bar;
        __builtin_amdgcn_s_waitcnt(0);
        unsigned nloc = b.st[0], nx = b.st[1];
        if (nloc == 0u) { xcd_barrier_complete(bar, b.x, nloc, nx); b.st[0] = nloc; b.st[1] = nx; }
        const unsigned old = xb_add(&bar[XB_XSUB(b.x)], 1u);
        const unsigned gen = old / nloc;
        if (old + 1u == (gen + 1u) * nloc) {
            __builtin_amdgcn_fence(__ATOMIC_RELEASE, "agent");
            asm volatile("s_waitcnt vmcnt(0)" ::: "memory");
            const unsigned og = xb_add(&bar[XB_TOP], 1u);
            const unsigned tg = og / nx;
            if (og + 1u == (tg + 1u) * nx) xb_add(&bar[XB_TOPGEN], 1u);
            else XB_SPIN(xb_ld(&bar[XB_TOPGEN]) == tg, bar);
            __builtin_amdgcn_fence(__ATOMIC_ACQUIRE, "agent");
            xb_add(&bar[XB_XGEN(b.x)], 1u);
            asm volatile("s_waitcnt vmcnt(0)" ::: "memory");
        } else {
            XB_SPIN(xb_ld(&bar[XB_XGEN(b.x)]) == gen, bar);
            __builtin_amdgcn_fence(__ATOMIC_ACQUIRE, "agent");
            asm volatile("s_waitcnt vmcnt(0)" ::: "memory");
        }
    }
    __syncthreads();
}

constexpr int PTAB_OFF = 143360;
__device__ __forceinline__ const void* ldptr(volatile LAS unsigned long long* t, int i) {
    const unsigned long long v = t[i];
    const unsigned lo = __builtin_amdgcn_readfirstlane((unsigned)v), hi = __builtin_amdgcn_readfirstlane((unsigned)(v >> 32));
    return (const void*)(const __attribute__((address_space(1))) void*)(((unsigned long long)hi << 32) | lo);
}
#ifndef PHMASK
#define PHMASK 0xFFFF
#endif
#define PHON(i) ((PHMASK >> (i)) & 1)
#ifndef REPMASK
#define REPMASK 0
#endif
#define NREP(i) (((REPMASK >> (i)) & 1) ? 2 : 1)
__global__ void __launch_bounds__(512, 2) fwd_kernel(Args a) {
    extern __shared__ __attribute__((aligned(16))) unsigned char smem_raw[];
    LAS unsigned char* lds = (LAS unsigned char*)smem_raw;
    cg::grid_group grid = cg::this_grid();
    const int nb = gridDim.x, bid = blockIdx.x;
    volatile LAS unsigned long long* ptab = (volatile LAS unsigned long long*)(lds + PTAB_OFF);
    if (threadIdx.x == 0) {
#pragma unroll
        for (int i = 0; i < 34; ++i) ptab[i] = (unsigned long long)a.in[i];
        ptab[34] = (unsigned long long)a.out; ptab[35] = (unsigned long long)a.ws;
        ((volatile LAS unsigned*)(lds + PTAB_OFF + 512))[0] = 0u; ((volatile LAS unsigned*)(lds + PTAB_OFF + 512))[1] = 0u;
    }
    __syncthreads();
    { const XcdBarrier xb0 = xcd_barrier_post((unsigned*)a.ws, (volatile LAS unsigned*)(lds + PTAB_OFF + 512)); if (threadIdx.x == 0) ((volatile LAS unsigned*)(lds + PTAB_OFF + 512))[2] = xb0.x; }
    __syncthreads();
    const int ph_lo = a.ph_lo, ph_hi = a.ph_hi;
#define INP(i) ((const float*)ldptr(ptab, (i)))

    for (int ph = ph_lo; ph < ph_hi; ++ph) {
        unsigned char* ws = (unsigned char*)ldptr(ptab, 35);
        float* const outp = (float*)ldptr(ptab, 34);
        const int* pos = (const int*)INP(1);
        int tid = threadIdx.x; asm volatile("" : "+v"(tid));
        const int wid = tid >> 6, lane = tid & 63;
        const long gtid = (long)bid * 512 + tid, gth = (long)nb * 512;
        float* ssq = (float*)(ws + WS_SSQP);
        float* sqq = (float*)(ws + WS_SQQ); float* sqkv = (float*)(ws + WS_SQKV);
#define SSQI(i) (ssq + (size_t)((i) & 1) * MTOK * 16)
        bf16_t* XB = (bf16_t*)(ws + WS_XB); bf16_t* U = (bf16_t*)(ws + WS_U);
        if (PHON(0) && ph == 0) {
          for (int rep = 0; rep < NREP(0); ++rep) {
            for (int row = bid * 8 + wid; row < MTOK; row += nb * 8) {
                const float* xr = INP(0) + (size_t)row * DM; float sq = 0.f;
#pragma unroll
                for (int i = 0; i < 2; ++i) {
                    const int c = i * 512 + lane * 8;
                    const f32x4 x0 = *(const f32x4*)(xr + c), x1 = *(const f32x4*)(xr + c + 4);
                    float v[8] = {x0[0], x0[1], x0[2], x0[3], x1[0], x1[1], x1[2], x1[3]};
#pragma unroll
                    for (int j = 0; j < 8; ++j) sq += v[j] * v[j];
                    *(u32x4*)(XB + (size_t)row * DM + c) = pk8(v);
                }
                sq = wavesum(sq);
                if (lane == 0) { float* sp = ssq + (size_t)row * 16; *(f32x4*)sp = (f32x4){sq, 0.f, 0.f, 0.f}; *(f32x4*)(sp + 4) = (f32x4){0.f, 0.f, 0.f, 0.f}; *(f32x4*)(sp + 8) = (f32x4){0.f, 0.f, 0.f, 0.f}; *(f32x4*)(sp + 12) = (f32x4){0.f, 0.f, 0.f, 0.f}; }
            }
            convert_region_a(ptab, 0, gtid, gth);
            if (nb < 256) convert_region_b(ptab, 0, gtid, gth);
          }
        } else if (PHON(1) && ph == 19) {
            const float* fg = INP(33);
            for (int row = bid * 8 + wid; row < MTOK; row += nb * 8) {
                float* xr = outp + (size_t)row * DM;
                f32x4 xv[4]; float sq = 0.f;
#pragma unroll
                for (int i = 0; i < 4; ++i) { xv[i] = *(const f32x4*)(xr + i * 256 + lane * 4); sq += xv[i][0] * xv[i][0] + xv[i][1] * xv[i][1] + xv[i][2] * xv[i][2] + xv[i][3] * xv[i][3]; }
                sq = wavesum(sq);
                const float rs = rsqrtf(sq * (1.0f / DM) + NEPS);
#pragma unroll
                for (int i = 0; i < 4; ++i) { const int c = i * 256 + lane * 4; const f32x4 g = *(const f32x4*)(fg + c); *(f32x4*)(xr + c) = xv[i] * rs * g; }
            }
        } else {
            const int l = (ph - 1) / 9, k = (ph - 1) % 9;
            pg8::StaticOrder S;
            auto do_conv = [&](long cg0, long cgt) {
                const float* cw = INP(9) + l * 768;
                for (long it = cg0; it < (long)MTOK * 32; it += cgt) {
                    const int tok = (int)(it >> 5), c8 = (int)(it & 31) * 8, t = tok & (SEQ - 1);
                    float acc8[8] = {0.f, 0.f, 0.f, 0.f, 0.f, 0.f, 0.f, 0.f};
#pragma unroll
                    for (int j = 0; j < 3; ++j) {
                        const int tt = t + j - 1;
                        if (tt >= 0 && tt < SEQ) {
                            const bf16_t* ur = U + (size_t)(tok + j - 1) * NU;
                            float cx[8], cc[8]; unpk8(*(const u32x4*)(ur + U_CX + c8), cx); unpk8(*(const u32x4*)(ur + U_CC + c8), cc);
#pragma unroll
                            for (int i = 0; i < 8; ++i) acc8[i] += cw[j * 256 + c8 + i] * (cx[i] * cc[i]);
                        }
                    }
                    bf16_t* bp = U + (size_t)tok * NU + U_CB + c8; float cb[8]; unpk8(*(const u32x4*)bp, cb);
#pragma unroll
                    for (int i = 0; i < 8; ++i) acc8[i] *= cb[i];
                    *(u32x4*)bp = pk8(acc8);
                }
            };
            if (PHON(2) && (k == 0 || k == 7)) {
                const int f2 = (k == 7);
                pg8::Gemm g{XB, (const bf16_t*)(ws + (f2 ? WS_WGU2 : WS_WGU1)), MTOK, 2 * FF, DM, DM, 512};
                pg8::EpiGU E{SSQI(3 * l + (f2 ? 2 : 0)), U};
                S.init(MTOK, 2 * FF, nb, bid);
                for (int rep = 0; rep < NREP(1); ++rep) pg8::gemm_phase(lds, g, S, E, tid);
            } else if (PHON(3) && (k == 1 || k == 8 || k == 6)) {
                pg8::Gemm g; pg8::EpiRes E;
                if (k == 6) { g = pg8::Gemm{U + U_CB, (const bf16_t*)(ws + WS_WOUT), MTOK, DM, DM, NU, 768 * 2}; E = pg8::EpiRes{outp, outp, XB, SSQI(3 * l + 2), 1.0f, 0}; }
                else { const int f2 = (k == 8);
                    g = pg8::Gemm{U, (const bf16_t*)(ws + (f2 ? WS_WD2 : WS_WD1)), MTOK, DM, FF, FF, 512};
                    E = pg8::EpiRes{(l == 0 && !f2) ? INP(0) : outp, outp, XB, SSQI(3 * l + (f2 ? 3 : 1)), 0.5f, 0}; }
                S.init(MTOK, DM, nb, bid);
                { const int nr = (k == 6) ? NREP(9) : NREP(8); for (int rep = 0; rep < nr; ++rep) { E.dry = (rep + 1 < nr) ? 1 : ((k == 8 && l == 1) ? -1 : 0); pg8::gemm_phase(lds, g, S, E, tid); } }
            } else if (PHON(4) && k == 2) {
                pg8::Gemm g{XB, (const bf16_t*)(ws + WS_WIN), MTOK, NU, DM, DM, 512};
                pg8::EpiWin E{SSQI(3 * l + 1), pos, U, sqq, sqkv, (bf16_t*)(ws + WS_KR), (bf16_t*)(ws + WS_VTR)};
                S.init(MTOK, NU, nb, bid);
                for (int rep = 0; rep < NREP(2); ++rep) pg8::gemm_phase(lds, g, S, E, tid);
            } else if (PHON(5) && k == 3) {
                if (PHON(8)) {   pg8::Gemm g{U + U_LORA, (const bf16_t*)(ws + WS_WLORA), MTOK, 1280, 384, NU, 512};
                    pg8::EpiLora E{ws, INP(10) + l * 256, INP(11) + l * 256, INP(14) + l * 256, INP(15) + l * 256};
                    S.init(MTOK, 1280, nb, bid);
                    for (int rep = 0; rep < NREP(3); ++rep) pg8::gemm_phase(lds, g, S, E, tid); }
                if (PHON(9)) {   pg8::Gemm g{U + U_QA, (const bf16_t*)(ws + WS_WMLA), MTOK, 1024, 512, NU, 512};
                    pg8::EpiMla E{sqq, sqkv, pos, (bf16_t*)(ws + WS_QM), (bf16_t*)(ws + WS_KN), (bf16_t*)(ws + WS_VTM)};
                    S.init(MTOK, 1024, nb, bid);
                    for (int rep = 0; rep < NREP(3); ++rep) pg8::gemm_phase(lds, g, S, E, tid); }
                if (PHON(10) && nb < 256) do_conv(gtid, gth);
            } else if (PHON(6) && k == 4) {
                if (nb >= 256 && bid >= 128) do_conv((long)(bid - 128) * 512 + tid, (long)128 * 512);
                for (int rep = 0; rep < NREP(4); ++rep) for (int sx = bid; sx < 128; sx += nb) rwkv_scan(lds, ws, INP(19) + l * 256, INP(20) + l * 256, sx, tid);
                for (int rep = 0; rep < NREP(5); ++rep) {
                    unsigned* ctr = (unsigned*)ws + 3600 + l + 2 * rep;
                    volatile LAS unsigned* uw = (volatile LAS unsigned*)(lds + PTAB_OFF + 640);
                    const float* gng = INP(24) + l * 256;
                    const int ocol = (rep + 1 < NREP(5)) ? U_TV : U_TG;
                    for (;;) {
                        __syncthreads();
                        if (tid == 0) *uw = atomicAdd(ctr, 1u);
                        __syncthreads();
                        const int unit = __builtin_amdgcn_readfirstlane(*uw);
                        if (unit >= 512) break;
                        if (unit < 256) attn_unit<0>(lds, ws, nullptr, unit, tid); else attn_unit<1>(lds, ws, gng, unit - 256, tid, ocol);
                    }
                }
                if (nb >= 256 && bid >= 128) {
                    const long g2 = (long)(bid - 128) * 512 + tid, gt2 = (long)128 * 512;
                    if (l == 0) { convert_region_b(ptab, 0, g2, gt2); convert_region_a(ptab, 1, g2, gt2); } else convert_region_b(ptab, 1, g2, gt2);
                } else if (nb < 256) { if (l == 0) convert_region_a(ptab, 1, gtid, gth); else convert_region_b(ptab, 1, gtid, gth); }
            } else if (PHON(7) && k == 5) {
                const bf16_t* YF = (const bf16_t*)(ws + WS_YF); const bf16_t* YB = (const bf16_t*)(ws + WS_YB);
                const bf16_t* AF = (const bf16_t*)(ws + WS_AF); const bf16_t* AB = (const bf16_t*)(ws + WS_AB); const bf16_t* GG = (const bf16_t*)(ws + WS_GG);
                const float* k_a = INP(20) + l * 256; const float* r_k = INP(21) + l * 256; const float* lg = INP(22) + l * 256; const float* lb = INP(23) + l * 256;
                for (int rep = 0; rep < NREP(7); ++rep)
                for (int gidx = bid * 32 + (tid >> 4); gidx < MTOK * 4; gidx += nb * 32) {
                    const int tok = gidx >> 2, h = gidx & 3, ch = h * 64 + 4 * (tid & 15);
                    const size_t lr = (size_t)tok * 256 + ch; bf16_t* ur = U + (size_t)tok * NU;
                    const u32x2 wf = *(const u32x2*)(YF + lr), wb = *(const u32x2*)(YB + lr);
                    f32x4 y = {bflo(wf.x) + bflo(wb.x), bfhi(wf.x) + bfhi(wb.x), bflo(wf.y) + bflo(wb.y), bfhi(wf.y) + bfhi(wb.y)};
                    const float mu = rowsum16(y[0] + y[1] + y[2] + y[3]) * (1.0f / 64.0f);
                    const f32x4 d = y - mu;
                    const float var = rowsum16(d[0] * d[0] + d[1] * d[1] + d[2] * d[2] + d[3] * d[3]) * (1.0f / 64.0f);
                    const float rsd = rsqrtf(var + 64e-5f);
                    const u32x2 wr_ = *(const u32x2*)(ur + U_RR + ch), wk_ = *(const u32x2*)(ur + U_RK + ch), wv_ = *(const u32x2*)(ur + U_RV + ch);
                    const u32x2 waf = *(const u32x2*)(AF + lr), wab = *(const u32x2*)(AB + lr), wg_ = *(const u32x2*)(GG + lr);
                    const f32x4 r4 = {bflo(wr_.x), bfhi(wr_.x), bflo(wr_.y), bfhi(wr_.y)}, k4 = {bflo(wk_.x), bfhi(wk_.x), bflo(wk_.y), bfhi(wk_.y)}, v4 = {bflo(wv_.x), bfhi(wv_.x), bflo(wv_.y), bfhi(wv_.y)};
                    const f32x4 af = {bflo(waf.x), bfhi(waf.x), bflo(waf.y), bfhi(waf.y)}, ab = {bflo(wab.x), bfhi(wab.x), bflo(wab.y), bfhi(wab.y)}, g4 = {bflo(wg_.x), bfhi(wg_.x), bflo(wg_.y), bfhi(wg_.y)};
                    const f32x4 ka = *(const f32x4*)(k_a + ch), rk = *(const f32x4*)(r_k + ch), lg4 = *(const f32x4*)(lg + ch), lb4 = *(const f32x4*)(lb + ch);
                    const f32x4 ksum = k4 * (2.0f + (af + ab - 2.0f) * ka);
                    const f32x4 pr = r4 * ksum * rk;
                    const float bs = rowsum16(pr[0] + pr[1] + pr[2] + pr[3]);
                    const f32x4 o = (d * rsd * lg4 + lb4 + bs * v4) * g4;
                    u32x2 w; w.x = pk2(o[0], o[1]); w.y = pk2(o[2], o[3]);
                    *(u32x2*)(ur + (rep + 1 < NREP(7) ? U_TV : U_RR) + ch) = w;
                }

            }
        }
        if (ph + 1 < ph_hi) {
            if (ph_hi > 1000) grid.sync();
            { XcdBarrier xb; xb.st = (volatile LAS unsigned*)(lds + PTAB_OFF + 512); xb.bar = (unsigned*)ldptr(ptab, 35); xb.x = __builtin_amdgcn_readfirstlane(xb.st[2]); xcd_barrier(xb); if (NREP(10) > 1) { xcd_barrier(xb); xcd_barrier(xb); } }
        }
    }
}

#ifndef RUNMASK
#define RUNMASK 0xFFFFF
#endif
#ifndef MK_MULTI
#define MK_MULTI 0
#endif
extern "C" void kernel_launch(void* const* d_in, const int* in_sizes, int n_in, void* d_out, int out_size, void* d_ws, size_t ws_size, hipStream_t stream) {
    static int grid = 0;
    if (grid == 0) {
        if (n_in != 34 || ws_size < WS_END) { fprintf(stderr, "kernel_launch: unexpected n_in %d / ws %zu\n", n_in, ws_size); grid = -1; return; }
        if (hipFuncSetAttribute((const void*)fwd_kernel, hipFuncAttributeMaxDynamicSharedMemorySize, LDS_BYTES) != hipSuccess) { fprintf(stderr, "hipFuncSetAttribute failed\n"); grid = -1; return; }
        int dev = 0, cus = 0, per_cu = 0;
        hipGetDevice(&dev); hipDeviceGetAttribute(&cus, hipDeviceAttributeMultiprocessorCount, dev);
        hipOccupancyMaxActiveBlocksPerMultiprocessor(&per_cu, (const void*)fwd_kernel, 512, LDS_BYTES);
        (void)hipGetLastError();
        if (per_cu < 1) fprintf(stderr, "occupancy query says %d blocks per CU\n", per_cu);
        grid = cus > 0 ? cus : 256;
    }
    if (grid < 0) return;
    Args a{};
    for (int i = 0; i < 34; ++i) a.in[i] = (const float*)d_in[i];
    a.out = (float*)d_out; a.ws = (unsigned char*)d_ws;
    if (hipMemsetAsync(d_ws, 0, 16384, stream) != hipSuccess) { fprintf(stderr, "memset failed\n"); return; }
#if MK_MULTI
    for (int p = 0; p < 20; ++p) { if (!((RUNMASK >> p) & 1)) continue; a.ph_lo = p; a.ph_hi = p + 1; hipLaunchKernelGGL(fwd_kernel, dim3(grid), dim3(512), LDS_BYTES, stream, a); }
#else
    a.ph_lo = 0; a.ph_hi = 20;
    void* args[] = {&a};
    hipError_t e = hipLaunchCooperativeKernel((const void*)fwd_kernel, dim3(grid), dim3(512), args, LDS_BYTES, stream);
    if (e != hipSuccess) fprintf(stderr, "cooperative launch failed: %s (grid %d)\n", hipGetErrorString(e), grid);
#endif
}
```

```cpp
#include <hip/hip_runtime.h>
#include <hip/hip_cooperative_groups.h>
#include <cstdint>
#include <cstdio>
namespace cg = cooperative_groups;

#define LAS __attribute__((address_space(3)))
typedef unsigned short bf16_t;
typedef short bf16x8 __attribute__((ext_vector_type(8)));
typedef short s16x4 __attribute__((ext_vector_type(4)));
typedef float f32x4 __attribute__((ext_vector_type(4)));
typedef float f32x16 __attribute__((ext_vector_type(16)));
typedef float f32x2 __attribute__((ext_vector_type(2)));
typedef unsigned u32x4 __attribute__((ext_vector_type(4)));
typedef unsigned u32x2 __attribute__((ext_vector_type(2)));

constexpr int MTOK = 16384, SEQ = 2048, DM = 1024, FF = 2816, NU = 3584, INW = 3488;
constexpr float NEPS = 1e-6f;
constexpr int U_CX = 0, U_CB = 256, U_CC = 512, U_RK = 768, U_RR = 1024, U_RV = 1280, U_TQ = 1536, U_TG = 1792, U_TK = 2048,
              U_TV = 2304, U_QA = 2560, U_CKV = 2944, U_LORA = 3072, U_KR = 3456;
constexpr size_t MiB = 1u << 20;
constexpr size_t WS_SSQ = 0;
constexpr size_t WS_WGU1 = 1 * MiB, WS_WD1 = 12 * MiB, WS_WIN = 17 * MiB + 512 * 1024, WS_WLORA = 24 * MiB + 512 * 1024, WS_WMLA = 25 * MiB + 512 * 1024;
constexpr size_t WS_WOUT = 27 * MiB, WS_WGU2 = 29 * MiB, WS_WD2 = 40 * MiB;
constexpr size_t WS_XB = 46 * MiB;
constexpr size_t WS_YF = 46 * MiB, WS_YB = 54 * MiB, WS_AB = 62 * MiB, WS_GG = 70 * MiB;
constexpr size_t WS_U = 78 * MiB;
constexpr size_t WS_EF = 190 * MiB, WS_EB = 198 * MiB, WS_AF = 206 * MiB;
constexpr size_t WS_QM = 214 * MiB, WS_KN = 226 * MiB, WS_KR = 234 * MiB, WS_VTM = 235 * MiB, WS_VTR = 243 * MiB, WS_END = 255 * MiB;
constexpr size_t WS_SSQP = 251 * MiB, WS_SQQ = 253 * MiB, WS_SQKV = 254 * MiB;
constexpr int LDS_BYTES = 147456;

struct Args { const float* in[34]; float* out; unsigned char* ws; int ph_lo, ph_hi; };

__device__ __forceinline__ unsigned f2bf(float f) { unsigned u = __float_as_uint(f); return (u + 0x7fffu + ((u >> 16) & 1u)) >> 16; }
typedef __bf16 hwbf16x2 __attribute__((ext_vector_type(2)));
__device__ __forceinline__ unsigned pk2(float lo, float hi) { const f32x2 v = {lo, hi}; return __builtin_bit_cast(unsigned, __builtin_convertvector(v, hwbf16x2)); }
__device__ __forceinline__ float bflo(unsigned w) { return __uint_as_float(w << 16); }
__device__ __forceinline__ float bfhi(unsigned w) { return __uint_as_float(w & 0xffff0000u); }
__device__ __forceinline__ u32x4 pk8(const float* v) { u32x4 w; w.x = pk2(v[0], v[1]); w.y = pk2(v[2], v[3]); w.z = pk2(v[4], v[5]); w.w = pk2(v[6], v[7]); return w; }
__device__ __forceinline__ void unpk8(u32x4 w, float* v) { v[0] = bflo(w.x); v[1] = bfhi(w.x); v[2] = bflo(w.y); v[3] = bfhi(w.y); v[4] = bflo(w.z); v[5] = bfhi(w.z); v[6] = bflo(w.w); v[7] = bfhi(w.w); }
__device__ __forceinline__ float sigmoidf_(float x) { return __builtin_amdgcn_rcpf(1.0f + __expf(-x)); }
template <int CTRL> __device__ __forceinline__ float dppf(float x) { return __int_as_float(__builtin_amdgcn_update_dpp(0, __float_as_int(x), CTRL, 0xF, 0xF, true)); }
__device__ __forceinline__ float rowsum16(float x) { x += dppf<0xB1>(x); x += dppf<0x4E>(x); x += dppf<0x124>(x); x += dppf<0x128>(x); return x; }
__device__ __forceinline__ float wavesum(float v) { for (int o = 32; o > 0; o >>= 1) v += __shfl_xor(v, o); return v; }
__device__ __forceinline__ float sum16(const float* p) { const f32x4 a = *(const f32x4*)p, b = *(const f32x4*)(p + 4), c = *(const f32x4*)(p + 8), d = *(const f32x4*)(p + 12);
    return (((a[0] + a[1]) + (a[2] + a[3])) + ((b[0] + b[1]) + (b[2] + b[3]))) + (((c[0] + c[1]) + (c[2] + c[3])) + ((d[0] + d[1]) + (d[2] + d[3]))); }
__device__ __forceinline__ float sum12(const float* p) { const f32x4 a = *(const f32x4*)p, b = *(const f32x4*)(p + 4), c = *(const f32x4*)(p + 8);
    return (((a[0] + a[1]) + (a[2] + a[3])) + ((b[0] + b[1]) + (b[2] + b[3]))) + ((c[0] + c[1]) + (c[2] + c[3])); }
__device__ __forceinline__ float sum4(const float* p) { const f32x4 a = *(const f32x4*)p; return (a[0] + a[1]) + (a[2] + a[3]); }
__device__ __forceinline__ float xfq(float v) { v += __shfl_xor(v, 16); v += __shfl_xor(v, 32); return v; }
__device__ __forceinline__ void rope_cs(int p, float inv, float& c, float& s) {
    const float ang = (float)p * inv; const float rev = ang * 0.15915494309189535f; const float fr = rev - floorf(rev);
    c = __builtin_amdgcn_cosf(fr); s = __builtin_amdgcn_sinf(fr);
}

namespace pg8 {
constexpr int BM = 256, BK = 64, HALF = 128, HTB = HALF * BK * 2, NXCD = 8, WGM = 8;
__host__ __device__ __forceinline__ int lds_byte(int r, int c) { const int st = (r >> 4) * 2 + (c >> 5), rr = r & 15, cc = c & 31, ob = rr * 64 + cc * 2; return st * 1024 + (ob ^ (((ob >> 9) & 1) << 5)); }
__host__ __device__ __forceinline__ void stage_rc(int b, int& R, int& C) { const int st = b / 1024, sb = b % 1024, swz = sb ^ (((sb >> 9) & 1) << 5); R = (st >> 1) * 16 + swz / 64; C = (st & 1) * 32 + (swz % 64) / 2; }
__host__ __device__ __forceinline__ int perm32(int rho) { const int n = rho >> 4, i = rho & 15; return 8 * (i >> 2) + 4 * n + (i & 3); }
struct Unit { int pm, pn; };
struct Gemm { const bf16_t* A; const bf16_t* Bt; int M, N, K, lda, kseg; };
struct StaticOrder {
    int nM, nN, nwg, G, c;
    __device__ void init(int M, int N, int G_, int c_) { nM = M / BM; nN = N / BM; nwg = nM * nN; G = G_; c = c_; }
    __device__ bool next(int i, Unit& u) const {
        const long L = (long)i * G + c; if (L >= nwg) return false;
        int wgid = (int)L; { const int q = nwg / NXCD, r = nwg % NXCD, xcd = wgid % NXCD, off = wgid / NXCD; wgid = (xcd < r ? xcd * (q + 1) : r * (q + 1) + (xcd - r) * q) + off; }
        const int nig = WGM * nN, gid = wgid / nig, fm = gid * WGM, gsz = (nM - fm) < WGM ? (nM - fm) : WGM;
        u.pm = fm + ((wgid % nig) % gsz); u.pn = (wgid % nig) / gsz; return true;
    }
};
template <class Epi, class Sched>
__device__ __forceinline__ void gemm_phase(LAS unsigned char* lds, const Gemm g, const Sched& S, const Epi& E, const int tid) {
    const int wid = __builtin_amdgcn_readfirstlane(tid >> 6), lane = tid & 63, wr = wid >> 2, wc = wid & 3, fr = lane & 15, fq = lane >> 4;
    const int K = g.K, nt = K / BK;
    unsigned voffA[2], voffB[2];
#pragma unroll
    for (int i = 0; i < 2; ++i) { int R, C; stage_rc(tid * 16 + i * 8192, R, C); const int Rb = (R & ~31) + perm32(R & 31);
        voffA[i] = (unsigned)(R * g.lda + C) * 2u; voffB[i] = (unsigned)(Rb * K + C) * 2u; }
    const size_t kstep = (size_t)(BK * 2);
    const size_t hstepA = (size_t)HALF * g.lda * 2, tstepA = 2 * hstepA;
    const size_t hstepB = (size_t)HALF * K * 2, tstepB = 2 * hstepB;
    const size_t kseg = (size_t)g.kseg;
    const unsigned ldsw = (unsigned)wid * 1024u;
    const int aoff = lds_byte(wr * 64 + fr, fq * 8), boff = lds_byte(wc * 32 + fr, fq * 8);
#define KOFFA(t) ((size_t)((t) >> 2) * kseg + (size_t)((t) & 3) * kstep)
#define PG8_SA(b, h) (((b) * 2 + (h)) * HTB)
#define PG8_SB(b, h) ((4 + (b) * 2 + (h)) * HTB)
#define PG8_STAGE(bufoff, gbase, voff) do { _Pragma("unroll") for (int _i = 0; _i < 2; ++_i) { unsigned _vo = (voff)[_i]; asm volatile("" : "+v"(_vo)); \
        __builtin_amdgcn_global_load_lds((const unsigned*)((const char*)(gbase) + _vo), (LAS unsigned*)(lds + (bufoff) + ldsw + _i * 8192), 16, 0, 0); } } while (0)
#define PG8_LDA(dst, b, h) do { _Pragma("unroll") for (int m = 0; m < 4; ++m) _Pragma("unroll") for (int k = 0; k < 2; ++k) dst[m][k] = *(const LAS bf16x8*)(lds + PG8_SA(b, h) + aoff + m * 2048 + k * 1024); } while (0)
#define PG8_LDB(dst, b, h) do { _Pragma("unroll") for (int n = 0; n < 2; ++n) _Pragma("unroll") for (int k = 0; k < 2; ++k) dst[n][k] = *(const LAS bf16x8*)(lds + PG8_SB(b, h) + boff + n * 2048 + k * 1024); } while (0)
#define PG8_MMA(ai, bj, At, Bt) do { __builtin_amdgcn_s_setprio(1); _Pragma("unroll") for (int m = 0; m < 4; ++m) _Pragma("unroll") for (int n = 0; n < 2; ++n) _Pragma("unroll") for (int k = 0; k < 2; ++k) \
        acc[ai][bj][m][n] = __builtin_amdgcn_mfma_f32_16x16x32_bf16(Bt[n][k], At[m][k], acc[ai][bj][m][n], 0, 0, 0); __builtin_amdgcn_s_setprio(0); } while (0)
#define PG8_WAIT_V(n) asm volatile("s_waitcnt vmcnt(" #n ")" ::: "memory")
#define PG8_WAIT_L(n) asm volatile("s_waitcnt lgkmcnt(" #n ")" ::: "memory")
#define PG8_BAR __builtin_amdgcn_s_barrier()
#define PG8_SCHED __builtin_amdgcn_sched_barrier(0)
    Unit cur, nxt; int ui = 0;
    if (!S.next(0, cur)) return;
    f32x4 acc[2][2][4][2];
#pragma unroll
    for (int a = 0; a < 2; ++a)
#pragma unroll
        for (int b = 0; b < 2; ++b)
#pragma unroll
            for (int m = 0; m < 4; ++m)
#pragma unroll
                for (int n = 0; n < 2; ++n) acc[a][b][m][n] = (f32x4){0.f, 0.f, 0.f, 0.f};
    bf16x8 At[4][2], B0[2][2], B1[2][2];
    const char* cA = (const char*)g.A + (size_t)cur.pm * tstepA; const char* cB = (const char*)g.Bt + (size_t)cur.pn * tstepB;
    PG8_STAGE(PG8_SB(0, 0), cB, voffB); PG8_STAGE(PG8_SB(0, 1), cB + hstepB, voffB); PG8_STAGE(PG8_SA(0, 0), cA, voffA); PG8_STAGE(PG8_SA(0, 1), cA + hstepA, voffA);
    if (wr == 1) PG8_BAR;
    PG8_WAIT_V(2); PG8_BAR;
    PG8_STAGE(PG8_SB(1, 0), cB + kstep, voffB); PG8_STAGE(PG8_SA(1, 0), cA + KOFFA(1), voffA); PG8_STAGE(PG8_SB(1, 1), cB + hstepB + kstep, voffB);
    PG8_WAIT_V(6); PG8_BAR;
    for (;;) {
        const bool has_next = S.next(ui + 1, nxt);
        const char* nA = has_next ? (const char*)g.A + (size_t)nxt.pm * tstepA : cA; const char* nB = has_next ? (const char*)g.Bt + (size_t)nxt.pn * tstepB : cB;
#pragma unroll 1
        for (int t = 0; t < nt; t += 2) {
            const bool last = (t == nt - 2);
            const char* a1 = cA + KOFFA(t + 1);
            const char* a2 = last ? nA : cA + KOFFA(t + 2); const char* b2 = last ? nB : cB + (size_t)(t + 2) * kstep;
            const char* a3 = last ? nA + KOFFA(1) : cA + KOFFA(t + 3); const char* b3 = b2 + kstep;
            PG8_LDB(B0, 0, 0); PG8_LDB(B1, 0, 1); PG8_SCHED; PG8_LDA(At, 0, 0); PG8_STAGE(PG8_SA(1, 1), a1 + hstepA, voffA);
            PG8_WAIT_V(8); PG8_WAIT_L(0); PG8_BAR; PG8_MMA(0, 0, At, B0); PG8_MMA(0, 1, At, B1); PG8_BAR; PG8_SCHED;
            PG8_LDA(At, 0, 1); PG8_STAGE(PG8_SB(0, 0), b2, voffB); PG8_STAGE(PG8_SB(0, 1), b2 + hstepB, voffB); PG8_STAGE(PG8_SA(0, 0), a2, voffA);
            PG8_WAIT_V(8); PG8_WAIT_L(0); PG8_BAR; PG8_MMA(1, 0, At, B0); PG8_MMA(1, 1, At, B1); PG8_BAR; PG8_SCHED;
            PG8_LDB(B0, 1, 0); PG8_LDB(B1, 1, 1); PG8_SCHED; PG8_LDA(At, 1, 0); PG8_STAGE(PG8_SA(0, 1), a2 + hstepA, voffA);
            PG8_WAIT_V(8); PG8_WAIT_L(0); PG8_BAR; PG8_MMA(0, 0, At, B0); PG8_MMA(0, 1, At, B1); PG8_BAR; PG8_SCHED;
            PG8_LDA(At, 1, 1); PG8_STAGE(PG8_SB(1, 0), b3, voffB); PG8_STAGE(PG8_SB(1, 1), b3 + hstepB, voffB); PG8_STAGE(PG8_SA(1, 0), a3, voffA);
            PG8_WAIT_V(8); PG8_WAIT_L(0); PG8_BAR; PG8_MMA(1, 0, At, B0); PG8_MMA(1, 1, At, B1); PG8_BAR; PG8_SCHED;
        }
        if (wr == 0) PG8_BAR;
        E(acc, cur, wr, wc, fr, fq);
        if (!has_next) break;
#pragma unroll
        for (int a = 0; a < 2; ++a)
#pragma unroll
            for (int b = 0; b < 2; ++b)
#pragma unroll
                for (int m = 0; m < 4; ++m)
#pragma unroll
                    for (int n = 0; n < 2; ++n) acc[a][b][m][n] = (f32x4){0.f, 0.f, 0.f, 0.f};
        cur = nxt; cA = nA; cB = nB; ++ui;
        if (wr == 1) PG8_BAR;
    }
    PG8_WAIT_V(0);
    PG8_BAR;
#undef KOFFA
#undef PG8_SA
#undef PG8_SB
#undef PG8_STAGE
#undef PG8_LDA
#undef PG8_LDB
#undef PG8_MMA
#undef PG8_WAIT_V
#undef PG8_WAIT_L
#undef PG8_BAR
#undef PG8_SCHED
}
typedef f32x4 Acc[2][2][4][2];

struct EpiGU {
    const float* ssq; bf16_t* H;
    __device__ __forceinline__ void operator()(const Acc& acc, const Unit& u, int wr, int wc, int fr, int fq) const {
        float rsv[8];
#pragma unroll
        for (int r8 = 0; r8 < 8; ++r8) { const int row = u.pm * BM + (r8 >> 2) * HALF + wr * 64 + (r8 & 3) * 16 + fr; rsv[r8] = sum4(ssq + (size_t)row * 16 + fq * 4); }
#pragma unroll
        for (int r8 = 0; r8 < 8; ++r8) rsv[r8] = rsqrtf(xfq(rsv[r8]) * (1.0f / DM) + NEPS);
#pragma unroll
        for (int ai = 0; ai < 2; ++ai)
#pragma unroll
            for (int m = 0; m < 4; ++m) {
                const int row = u.pm * BM + ai * HALF + wr * 64 + m * 16 + fr;
                const float rs = rsv[ai * 4 + m];
                float hv[8];
#pragma unroll
                for (int n = 0; n < 2; ++n)
#pragma unroll
                    for (int j = 0; j < 4; ++j) { const float gv = acc[ai][0][m][n][j] * rs, uv = acc[ai][1][m][n][j] * rs; hv[4 * n + j] = gv * sigmoidf_(gv) * uv; }
                *(u32x4*)(H + (size_t)row * FF + u.pn * HALF + wc * 32 + fq * 8) = pk8(hv);
            }
    }
};
struct EpiRes {
    const float* xin; float* xout; bf16_t* xb; float* ssq_next; float alpha; int dry;
    __device__ __forceinline__ void operator()(const Acc& acc, const Unit& u, int wr, int wc, int fr, int fq) const {
#pragma unroll
        for (int ai = 0; ai < 2; ++ai)
#pragma unroll
            for (int m = 0; m < 4; ++m) {
                const int row = u.pm * BM + ai * HALF + wr * 64 + m * 16 + fr;
                float sq = 0.f;
#pragma unroll
                for (int bj = 0; bj < 2; ++bj) {
                    const size_t off = (size_t)row * DM + u.pn * BM + bj * HALF + wc * 32 + fq * 8;
                    f32x4 x0 = *(const f32x4*)(xin + off), x1 = *(const f32x4*)(xin + off + 4);
                    x0 += alpha * acc[ai][bj][m][0]; x1 += alpha * acc[ai][bj][m][1];
                    if (dry <= 0) { *(f32x4*)(xout + off) = x0; *(f32x4*)(xout + off + 4) = x1; }
                    float v[8] = {x0[0], x0[1], x0[2], x0[3], x1[0], x1[1], x1[2], x1[3]};
                    if (dry >= 0) *(u32x4*)(xb + off) = pk8(v);
#pragma unroll
                    for (int j = 0; j < 8; ++j) sq += v[j] * v[j];
                }
                sq += __shfl_xor(sq, 16); sq += __shfl_xor(sq, 32);
                if (fq == 0) ssq_next[(size_t)row * 16 + u.pn * 4 + wc] = sq;
            }
    }
};
struct EpiWin {
    const float* ssq; const int* pos; bf16_t* U; float* ssq_q; float* ssq_kv; bf16_t* KR; bf16_t* VTR;
    __device__ __forceinline__ void operator()(const Acc& acc, const Unit& u, int wr, int wc, int fr, int fq) const {
        float rsv[8]; int posv[8];
#pragma unroll
        for (int r8 = 0; r8 < 8; ++r8) { const int row = u.pm * BM + (r8 >> 2) * HALF + wr * 64 + (r8 & 3) * 16 + fr; rsv[r8] = sum4(ssq + (size_t)row * 16 + fq * 4); posv[r8] = pos[row]; }
#pragma unroll
        for (int r8 = 0; r8 < 8; ++r8) rsv[r8] = rsqrtf(xfq(rsv[r8]) * (1.0f / DM) + NEPS);
#pragma unroll
        for (int bj = 0; bj < 2; ++bj) {
            const int hf = 2 * u.pn + bj;
            int mode = 0;
            if (hf == 12 || hf == 13 || hf == 16 || hf == 17) mode = 1; else if (hf == 18 || hf == 19) mode = 2; else if (hf >= 20 && hf <= 22) mode = 3;
            else if (hf == 23) mode = 4; else if (hf == 24) mode = 5; else if (hf == 26) mode = 6; else if (hf == 27) mode = 7;
            float inv[4];
#pragma unroll
            for (int q = 0; q < 4; ++q) { const int n = q >> 1, pp = q & 1;
                inv[q] = (mode == 7) ? exp2f(-(float)(4 * fq + 2 * n + pp) * (13.287712379549449f / 16.0f)) : exp2f(-(float)(16 * (wc & 1) + 4 * fq + 2 * n + pp) * (13.287712379549449f / 32.0f)); }
#pragma unroll
            for (int ai = 0; ai < 2; ++ai)
#pragma unroll
                for (int m = 0; m < 4; ++m) {
                    const int row = u.pm * BM + ai * HALF + wr * 64 + m * 16 + fr;
                    const float rs = rsv[ai * 4 + m];
                    float v[8];
#pragma unroll
                    for (int n = 0; n < 2; ++n)
#pragma unroll
                        for (int j = 0; j < 4; ++j) v[4 * n + j] = acc[ai][bj][m][n][j] * rs;
                    if (mode == 1 || mode == 7) {
                        const int p = posv[ai * 4 + m];
#pragma unroll
                        for (int q = 0; q < 4; ++q) { float c, s; rope_cs(p, inv[q], c, s); const float x1 = v[2 * q], x2 = v[2 * q + 1]; v[2 * q] = x1 * c - x2 * s; v[2 * q + 1] = x1 * s + x2 * c; }
                    } else if (mode == 5) {
#pragma unroll
                        for (int j = 0; j < 8; ++j) { const float e = __expf(2.0f * v[j]); v[j] = 1.0f - 2.0f * __builtin_amdgcn_rcpf(e + 1.0f); }
                    } else if (mode == 6) {
#pragma unroll
                        for (int j = 0; j < 8; ++j) v[j] = sigmoidf_(v[j]);
                    }
                    if (mode == 2) {
                        const int b = row >> 11, t = row & 2047, h = 2 * (hf - 18) + (wc >> 1), dv0 = 32 * (wc & 1) + 8 * fq;
                        bf16_t* vt = VTR + ((size_t)((b * 4 + h) * 64 + dv0)) * SEQ + t;
#pragma unroll
                        for (int j = 0; j < 8; ++j) vt[(size_t)j * SEQ] = (bf16_t)f2bf(v[j]);
                    } else if (mode == 7) {
                        if (wc == 0) *(u32x4*)(KR + (size_t)row * 32 + fq * 8) = pk8(v);
                    } else {
                        *(u32x4*)(U + (size_t)row * NU + hf * HALF + wc * 32 + fq * 8) = pk8(v);
                        if (mode == 3 || mode == 4) {
                            float sq = 0.f;
#pragma unroll
                            for (int j = 0; j < 8; ++j) sq += v[j] * v[j];
                            sq += __shfl_xor(sq, 16); sq += __shfl_xor(sq, 32);
                            if (fq == 0) { if (mode == 3) ssq_q[(size_t)row * 16 + (hf - 20) * 4 + wc] = sq; else ssq_kv[(size_t)row * 4 + wc] = sq; }
                        }
                    }
                }
        }
    }
};
struct EpiLora {
    unsigned char* ws; const float* b0; const float* b1; const float* b2; const float* b3;
    __device__ __forceinline__ void operator()(const Acc& acc, const Unit& u, int wr, int wc, int fr, int fq) const {
        const int comp = u.pn;
        bf16_t* D = (bf16_t*)(ws + (comp < 3 ? WS_EF + (size_t)comp * 8 * MiB : WS_AB + (size_t)(comp - 3) * 8 * MiB));
        const float* B = comp == 0 ? b0 : comp == 1 ? b1 : comp == 2 ? b2 : b3;
        const float c0 = comp < 2 ? 0.6065306597126334f : 1.0f;
        const bool act = comp < 4;
#pragma unroll
        for (int bj = 0; bj < 2; ++bj) {
            const int ch = bj * HALF + wc * 32 + fq * 8;
            f32x4 bb0 = {0.f, 0.f, 0.f, 0.f}, bb1 = {0.f, 0.f, 0.f, 0.f};
            if (act) { bb0 = *(const f32x4*)(B + ch); bb1 = *(const f32x4*)(B + ch + 4); }
#pragma unroll
            for (int ai = 0; ai < 2; ++ai)
#pragma unroll
                for (int m = 0; m < 4; ++m) {
                    const int row = u.pm * BM + ai * HALF + wr * 64 + m * 16 + fr;
                    const f32x4 x0 = acc[ai][bj][m][0] + bb0, x1 = acc[ai][bj][m][1] + bb1;
                    float v[8] = {x0[0], x0[1], x0[2], x0[3], x1[0], x1[1], x1[2], x1[3]};
                    if (act) {
#pragma unroll
                        for (int j = 0; j < 8; ++j) v[j] = c0 * sigmoidf_(v[j]);
                    }
                    *(u32x4*)(D + (size_t)row * 256 + ch) = pk8(v);
                }
        }
    }
};
struct EpiMla {
    const float* ssq_q; const float* ssq_kv; const int* pos; bf16_t* QM; bf16_t* KN; bf16_t* VTM;
    __device__ __forceinline__ void operator()(const Acc& acc, const Unit& u, int wr, int wc, int fr, int fq) const {
        float inv[4];
#pragma unroll
        for (int q = 0; q < 4; ++q) inv[q] = exp2f(-(float)(4 * fq + q) * (13.287712379549449f / 16.0f));
        float rsq[8], rskv[8]; int posv[8];
#pragma unroll
        for (int r8 = 0; r8 < 8; ++r8) { const int row = u.pm * BM + (r8 >> 2) * HALF + wr * 64 + (r8 & 3) * 16 + fr; rsq[r8] = fq < 3 ? sum4(ssq_q + (size_t)row * 16 + fq * 4) : 0.f; rskv[r8] = ssq_kv[(size_t)row * 4 + fq]; posv[r8] = pos[row]; }
#pragma unroll
        for (int r8 = 0; r8 < 8; ++r8) { rsq[r8] = rsqrtf(xfq(rsq[r8]) * (1.0f / 384.0f) + NEPS); rskv[r8] = rsqrtf(xfq(rskv[r8]) * (1.0f / 128.0f) + NEPS); }
#pragma unroll
        for (int bj = 0; bj < 2; ++bj) {
            const int n0 = u.pn * BM + bj * HALF + wc * 32;
            if (n0 >= 896) continue;
            const bool isq = n0 < 384;
            const bool isrope = isq && ((n0 >> 5) % 3 == 2);
            const int nn = n0 - 384, hh = nn >> 7, c0 = nn & 127;
#pragma unroll
            for (int ai = 0; ai < 2; ++ai)
#pragma unroll
                for (int m = 0; m < 4; ++m) {
                    const int row = u.pm * BM + ai * HALF + wr * 64 + m * 16 + fr;
                    const float rs = isq ? rsq[ai * 4 + m] : rskv[ai * 4 + m];
                    float v[8];
#pragma unroll
                    for (int n = 0; n < 2; ++n)
#pragma unroll
                        for (int j = 0; j < 4; ++j) v[4 * n + j] = acc[ai][bj][m][n][j] * rs;
                    if (isq) {
                        if (isrope) { const int p = posv[ai * 4 + m];
#pragma unroll
                            for (int q = 0; q < 4; ++q) { float c, s; rope_cs(p, inv[q], c, s); const float x1 = v[2 * q], x2 = v[2 * q + 1]; v[2 * q] = x1 * c - x2 * s; v[2 * q + 1] = x1 * s + x2 * c; } }
                        *(u32x4*)(QM + (size_t)row * 384 + n0 + fq * 8) = pk8(v);
                    } else if (c0 < 64) {
                        *(u32x4*)(KN + (size_t)row * 256 + hh * 64 + c0 + fq * 8) = pk8(v);
                    } else {
                        const int b = row >> 11, t = row & 2047, dv0 = c0 - 64 + 8 * fq;
                        bf16_t* vt = VTM + ((size_t)((b * 4 + hh) * 64 + dv0)) * SEQ + t;
#pragma unroll
                        for (int j = 0; j < 8; ++j) vt[(size_t)j * SEQ] = (bf16_t)f2bf(v[j]);
                    }
                }
        }
    }
};
}

template <int MODE>
__device__ __forceinline__ void attn_unit(LAS unsigned char* lds, unsigned char* ws, const float* gn_g, int unit, const int tid, const int ocol = U_TG) {
    constexpr int DQK = MODE == 0 ? 96 : 64, NS = DQK / 16, KS = (DQK + 8) * 2, VS = 136, KBUF = 64 * KS, VBUF = 64 * VS, CPR = DQK / 8, NKC = 64 * CPR;
    const int wid = tid >> 6, lane = tid & 63, ql = lane & 31, hi = lane >> 5;
    const int b = unit >> 5, h = (unit >> 3) & 3, qb = unit & 7;
    const int tok0 = b * SEQ, qi = qb * 256 + wid * 32 + ql;
    bf16_t* U = (bf16_t*)(ws + WS_U);
    const bf16_t* QM = (const bf16_t*)(ws + WS_QM); const bf16_t* KN = (const bf16_t*)(ws + WS_KN); const bf16_t* KR = (const bf16_t*)(ws + WS_KR);
    const bf16_t* VT = (const bf16_t*)(ws + (MODE == 0 ? WS_VTM : WS_VTR)) + (size_t)((b * 4 + h) * 64) * SEQ;
    bf16x8 qf[NS];
    { const bf16_t* qrow = MODE == 0 ? QM + (size_t)(tok0 + qi) * 384 + h * 96 : U + (size_t)(tok0 + qi) * NU + U_TQ + h * 64;
#pragma unroll
      for (int s = 0; s < NS; ++s) qf[s] = *(const bf16x8*)(qrow + 16 * s + 8 * hi); }
    const int kc0 = tid, kc1 = tid + 512;
    const int vdv = tid >> 3, vcc = tid & 7;
    u32x4 kreg0, kreg1 = {0, 0, 0, 0}, vreg;
    auto kaddr = [&](int c, int j0) -> const bf16_t* {
        const int key = c / CPR, cc = c % CPR; const size_t tok = (size_t)(tok0 + j0 + key);
        if (MODE == 0) return cc < 8 ? KN + tok * 256 + h * 64 + cc * 8 : KR + tok * 32 + (cc - 8) * 8;
        return U + tok * NU + U_TK + h * 64 + cc * 8;
    };
    auto gload = [&](int j0) {
        kreg0 = *(const u32x4*)kaddr(kc0, j0);
        if (kc1 < NKC) kreg1 = *(const u32x4*)kaddr(kc1, j0);
        vreg = *(const u32x4*)(VT + (size_t)vdv * SEQ + j0 + vcc * 8);
    };
    auto lwrite = [&](int buf) {
        LAS unsigned char* kb = lds + buf * KBUF; LAS unsigned char* vb = lds + 2 * KBUF + buf * VBUF;
        *(LAS u32x4*)(kb + (kc0 / CPR) * KS + (kc0 % CPR) * 16) = kreg0;
        if (kc1 < NKC) *(LAS u32x4*)(kb + (kc1 / CPR) * KS + (kc1 % CPR) * 16) = kreg1;
        *(LAS u32x2*)(vb + vdv * VS + vcc * 16) = (u32x2){vreg.x, vreg.y};
        *(LAS u32x2*)(vb + vdv * VS + vcc * 16 + 8) = (u32x2){vreg.z, vreg.w};
    };
    f32x16 ot[2];
#pragma unroll
    for (int i = 0; i < 16; ++i) { ot[0][i] = 0.f; ot[1][i] = 0.f; }
    float mrun = -1e30f, lrun = 0.f;
    const float lgam = MODE == 1 ? log2f(1.0f - exp2f(-5.0f - (float)h)) : 0.f;
    __syncthreads();
    gload(0); lwrite(0);
    __syncthreads();
    constexpr int NT = SEQ / 64;
    for (int t = 0; t < NT; ++t) {
        const int buf = t & 1;
        if (t + 1 < NT) gload((t + 1) * 64);
        LAS unsigned char* kb = lds + buf * KBUF; LAS unsigned char* vb = lds + 2 * KBUF + buf * VBUF;
        f32x16 st[2];
#pragma unroll
        for (int i = 0; i < 16; ++i) { st[0][i] = 0.f; st[1][i] = 0.f; }
        {
            bf16x8 kfr[2][NS];
#pragma unroll
            for (int kt2 = 0; kt2 < 2; ++kt2)
#pragma unroll
                for (int s = 0; s < NS; ++s) kfr[kt2][s] = *(const LAS bf16x8*)(kb + (32 * kt2 + ql) * KS + (16 * s + 8 * hi) * 2);
            __builtin_amdgcn_sched_barrier(0);
#pragma unroll
            for (int s = 0; s < NS; ++s)
#pragma unroll
                for (int kt2 = 0; kt2 < 2; ++kt2) st[kt2] = __builtin_amdgcn_mfma_f32_32x32x16_bf16(kfr[kt2][s], qf[s], st[kt2], 0, 0, 0);
        }
        u32x4 vfr[2][2][2];
#pragma unroll
        for (int kt2 = 0; kt2 < 2; ++kt2)
#pragma unroll
            for (int s2 = 0; s2 < 2; ++s2)
#pragma unroll
                for (int dt = 0; dt < 2; ++dt) {
                    LAS unsigned char* vp = vb + (32 * dt + ql) * VS + (32 * kt2 + 16 * s2 + 4 * hi) * 2;
                    const u32x2 v0 = *(const LAS u32x2*)vp, v1 = *(const LAS u32x2*)(vp + 16);
                    vfr[kt2][s2][dt] = (u32x4){v0.x, v0.y, v1.x, v1.y};
                }
        __builtin_amdgcn_sched_barrier(0);
        if (MODE == 0) {
            float mx = st[0][0];
#pragma unroll
            for (int i = 0; i < 16; ++i) { mx = fmaxf(mx, st[0][i]); mx = fmaxf(mx, st[1][i]); }
            mx = fmaxf(mx, __shfl_xor(mx, 32));
            const float mnew = fmaxf(mrun, mx), alpha = __builtin_amdgcn_exp2f(mrun - mnew);
            mrun = mnew; float ls = 0.f;
#pragma unroll
            for (int i = 0; i < 16; ++i) { st[0][i] = __builtin_amdgcn_exp2f(st[0][i] - mnew); st[1][i] = __builtin_amdgcn_exp2f(st[1][i] - mnew); ls += st[0][i] + st[1][i]; }
            lrun = lrun * alpha + ls;
            if (__builtin_amdgcn_ballot_w64(alpha != 1.0f)) {
#pragma unroll
                for (int i = 0; i < 16; ++i) { ot[0][i] *= alpha; ot[1][i] *= alpha; }
            }
        } else {
            const float dq = (float)(qi - (t * 64 + 4 * hi));
#pragma unroll
            for (int kt2 = 0; kt2 < 2; ++kt2)
#pragma unroll
                for (int i = 0; i < 16; ++i) { const float d = fabsf(dq - (float)(32 * kt2 + 8 * (i >> 2) + (i & 3))); st[kt2][i] *= __builtin_amdgcn_exp2f(lgam * d); }
        }
        {
#pragma unroll
            for (int kt2 = 0; kt2 < 2; ++kt2)
#pragma unroll
                for (int s2 = 0; s2 < 2; ++s2) {
                    u32x4 pw; pw.x = pk2(st[kt2][8 * s2 + 0], st[kt2][8 * s2 + 1]); pw.y = pk2(st[kt2][8 * s2 + 2], st[kt2][8 * s2 + 3]);
                    pw.z = pk2(st[kt2][8 * s2 + 4], st[kt2][8 * s2 + 5]); pw.w = pk2(st[kt2][8 * s2 + 6], st[kt2][8 * s2 + 7]);
                    const bf16x8 pf = __builtin_bit_cast(bf16x8, pw);
#pragma unroll
                    for (int dt = 0; dt < 2; ++dt) ot[dt] = __builtin_amdgcn_mfma_f32_32x32x16_bf16(__builtin_bit_cast(bf16x8, vfr[kt2][s2][dt]), pf, ot[dt], 0, 0, 0);
                }
        }
        if (t + 1 < NT) lwrite(buf ^ 1);
        __syncthreads();
    }
    const size_t orow = (size_t)(tok0 + qi) * NU;
    if (MODE == 0) {
        const float ltot = lrun + __shfl_xor(lrun, 32), il = 1.0f / ltot;
#pragma unroll
        for (int dt = 0; dt < 2; ++dt)
#pragma unroll
            for (int g = 0; g < 4; ++g) {
                u32x2 w; w.x = pk2(ot[dt][4 * g] * il, ot[dt][4 * g + 1] * il); w.y = pk2(ot[dt][4 * g + 2] * il, ot[dt][4 * g + 3] * il);
                *(u32x2*)(U + orow + U_QA + h * 64 + 32 * dt + 8 * g + 4 * hi) = w;
            }
    } else {
        float sq = 0.f;
#pragma unroll
        for (int i = 0; i < 16; ++i) sq += ot[0][i] * ot[0][i] + ot[1][i] * ot[1][i];
        sq += __shfl_xor(sq, 32);
        const float rs = rsqrtf(sq * (1.0f / 64.0f) + NEPS);
#pragma unroll
        for (int dt = 0; dt < 2; ++dt)
#pragma unroll
            for (int g = 0; g < 4; ++g) {
                const int dv = 32 * dt + 8 * g + 4 * hi;
                bf16_t* gp = U + orow + U_TG + h * 64 + dv;
                const u32x2 gw = *(const u32x2*)gp;
                const float g0 = bflo(gw.x), g1 = bfhi(gw.x), g2 = bflo(gw.y), g3 = bfhi(gw.y);
                const f32x4 gg = *(const f32x4*)(gn_g + h * 64 + dv);
                const float o0 = ot[dt][4 * g] * rs * gg[0] * g0 * sigmoidf_(g0), o1 = ot[dt][4 * g + 1] * rs * gg[1] * g1 * sigmoidf_(g1);
                const float o2 = ot[dt][4 * g + 2] * rs * gg[2] * g2 * sigmoidf_(g2), o3 = ot[dt][4 * g + 3] * rs * gg[3] * g3 * sigmoidf_(g3);
                u32x2 w; w.x = pk2(o0, o1); w.y = pk2(o2, o3);
                *(u32x2*)(U + orow + ocol + h * 64 + dv) = w;
            }
    }
}

struct ScOp { f32x4 w4, kk, nb, kd, r4; float v1; };
#define SC_LD(x, s) do { asm volatile("ds_read_b128 %0, %1 offset:%2" : "=v"(x.w4) : "v"(ao), "n"((s) * 1280)); asm volatile("ds_read_b128 %0, %1 offset:%2" : "=v"(x.kk) : "v"(ao), "n"((s) * 1280 + 256)); \
        asm volatile("ds_read_b128 %0, %1 offset:%2" : "=v"(x.nb) : "v"(ao), "n"((s) * 1280 + 512)); asm volatile("ds_read_b128 %0, %1 offset:%2" : "=v"(x.kd) : "v"(ao), "n"((s) * 1280 + 768)); \
        asm volatile("ds_read_b128 %0, %1 offset:%2" : "=v"(x.r4) : "v"(ao), "n"((s) * 1280 + 1024)); asm volatile("ds_read_b32 %0, %1 offset:%2" : "=v"(x.v1) : "v"(av), "n"((s) * 128)); } while (0)
#define SC_WAIT(x, n) asm volatile("s_waitcnt lgkmcnt(" #n ")" : "+v"(x.w4), "+v"(x.kk), "+v"(x.nb), "+v"(x.kd), "+v"(x.r4), "+v"(x.v1) :: "memory")
#define SC_UPD(x) do { p[0] = __builtin_fmaf(sa, x.nb[0], __builtin_fmaf(p[0], x.w4[0], x.v1 * x.kd[0])); p[1] = __builtin_fmaf(sa, x.nb[1], __builtin_fmaf(p[1], x.w4[1], x.v1 * x.kd[1])); \
        p[2] = __builtin_fmaf(sa, x.nb[2], __builtin_fmaf(p[2], x.w4[2], x.v1 * x.kd[2])); p[3] = __builtin_fmaf(sa, x.nb[3], __builtin_fmaf(p[3], x.w4[3], x.v1 * x.kd[3])); \
        ycar = __builtin_fmaf(p[3], x.r4[3], __builtin_fmaf(p[2], x.r4[2], __builtin_fmaf(p[1], x.r4[1], p[0] * x.r4[0]))); } while (0)
#define SC_MATH0(x) do { float sa = __builtin_fmaf(p[3], x.kk[3], __builtin_fmaf(p[2], x.kk[2], __builtin_fmaf(p[1], x.kk[1], p[0] * x.kk[0]))); sa = rowsum16(sa); SC_UPD(x); } while (0)
#define SC_MATH(x, s) do { float sa = __builtin_fmaf(p[3], x.kk[3], __builtin_fmaf(p[2], x.kk[2], __builtin_fmaf(p[1], x.kk[1], p[0] * x.kk[0]))); \
        sa += dppf<0xB1>(sa); ycar += dppf<0xB1>(ycar); sa += dppf<0x4E>(sa); ycar += dppf<0x4E>(ycar); sa += dppf<0x124>(sa); ycar += dppf<0x124>(ycar); sa += dppf<0x128>(sa); ycar += dppf<0x128>(ycar); \
        *(LAS float*)(yo + ((s) - 1) * 128) = ycar; SC_UPD(x); } while (0)
#define SC_STEP(cur, nxt, s, n) do { SC_LD(nxt, (s) + 1); SC_WAIT(cur, n); SC_MATH(cur, s); } while (0)
#define SC_STEP4(s) do { SC_STEP(ca, cb, s, 7); SC_STEP(cb, ca, (s) + 1, 7); SC_STEP(ca, cb, (s) + 2, 7); SC_STEP(cb, ca, (s) + 3, 7); } while (0)
__device__ __forceinline__ void rwkv_scan(LAS unsigned char* lds, unsigned char* ws, const float* k_k, const float* k_a, int sidx, const int tid) {
    constexpr int TC = 32, OPB = TC * 5 * 64 * 4, VVB = TC * 32 * 4, YOB = TC * 32 * 4;
    const int wid = tid >> 6, lane = tid & 63;
    const int scan = sidx >> 1, hb = sidx & 1, b = scan >> 3, h = (scan >> 1) & 3, dir = scan & 1;
    const bf16_t* U = (const bf16_t*)(ws + WS_U);
    const bf16_t* E = (const bf16_t*)(ws + (dir ? WS_EB : WS_EF)); const bf16_t* A = (const bf16_t*)(ws + (dir ? WS_AB : WS_AF));
    bf16_t* Y = (bf16_t*)(ws + (dir ? WS_YB : WS_YF));
    LAS unsigned char* ops = lds; LAS unsigned char* vvb = lds + 2 * OPB; LAS unsigned char* yob = lds + 2 * OPB + 2 * VVB;
    const int ts = tid >> 4, cj = tid & 15, ch = h * 64 + 4 * cj;
    const f32x4 kk_w = *(const f32x4*)(k_k + ch), ka_w = *(const f32x4*)(k_a + ch);
    struct G { u32x2 rk, rr, rv, re, ra; };
    auto gload = [&](int c) -> G {
        G g;
        const int sI = c * TC + ts, t = dir ? (SEQ - 1 - sI) : sI; const size_t row = (size_t)(b * SEQ + t);
        g.rk = *(const u32x2*)(U + row * NU + U_RK + ch); g.rr = *(const u32x2*)(U + row * NU + U_RR + ch); g.rv = *(const u32x2*)(U + row * NU + U_RV + ch);
        g.re = *(const u32x2*)(E + row * 256 + ch); g.ra = *(const u32x2*)(A + row * 256 + ch);
        return g;
    };
    auto lwrite = [&](int buf, const G& g) {
        const u32x2 rk = g.rk, rr = g.rr, rv = g.rv, re = g.re, ra = g.ra;
        const f32x4 k4 = {bflo(rk.x), bfhi(rk.x), bflo(rk.y), bfhi(rk.y)}, r4 = {bflo(rr.x), bfhi(rr.x), bflo(rr.y), bfhi(rr.y)}, v4 = {bflo(rv.x), bfhi(rv.x), bflo(rv.y), bfhi(rv.y)};
        const f32x4 e4 = {bflo(re.x), bfhi(re.x), bflo(re.y), bfhi(re.y)}, a4 = {bflo(ra.x), bfhi(ra.x), bflo(ra.y), bfhi(ra.y)};
        f32x4 kk = k4 * kk_w;
        float ss = kk[0] * kk[0] + kk[1] * kk[1] + kk[2] * kk[2] + kk[3] * kk[3];
        ss = rowsum16(ss);
        const float nrm = __builtin_amdgcn_rcpf(fmaxf(__builtin_amdgcn_sqrtf(ss), 1e-12f));
        kk = kk * nrm;
        const f32x4 nb = -(kk * a4);
        f32x4 w4; w4[0] = __expf(-e4[0]); w4[1] = __expf(-e4[1]); w4[2] = __expf(-e4[2]); w4[3] = __expf(-e4[3]);
        const f32x4 kd = k4 * (1.0f + (a4 - 1.0f) * ka_w);
        LAS unsigned char* o = ops + buf * OPB + ts * 1280 + cj * 16;
        *(LAS f32x4*)(o) = w4; *(LAS f32x4*)(o + 256) = kk; *(LAS f32x4*)(o + 512) = nb; *(LAS f32x4*)(o + 768) = kd; *(LAS f32x4*)(o + 1024) = r4;
        if ((cj >> 3) == hb) *(LAS f32x4*)(vvb + buf * VVB + ts * 128 + (cj & 7) * 16) = v4;
    };
    auto flush = [&](int c) {
#pragma unroll
        for (int i = 0; i < 2; ++i) {
            const int idx = tid + i * 512, s = idx >> 5, ri = idx & 31;
            const int sI = c * TC + s, t = dir ? (SEQ - 1 - sI) : sI;
            const float yv = *(const LAS float*)(yob + (c & 1) * YOB + s * 128 + ri * 4);
            Y[(size_t)(b * SEQ + t) * 256 + h * 64 + 32 * hb + ri] = (bf16_t)f2bf(yv);
        }
    };
    f32x4 p = {0.f, 0.f, 0.f, 0.f};
    const int rr4 = lane >> 4, lc = lane & 15, rowA = 4 * wid + rr4;
    auto compute = [&](int buf) {
        const unsigned ao = (unsigned)(unsigned long long)(ops + buf * OPB + lc * 16), av = (unsigned)(unsigned long long)(vvb + buf * VVB + rowA * 4);
        LAS unsigned char* yo = yob + buf * YOB + rowA * 4;
        ScOp ca, cb;
        SC_LD(ca, 0);
        float ycar = 0.f;
        SC_LD(cb, 1); SC_WAIT(ca, 6); SC_MATH0(ca); SC_STEP(cb, ca, 1, 6); SC_STEP(ca, cb, 2, 7); SC_STEP(cb, ca, 3, 7);
        SC_STEP4(4); SC_STEP4(8); SC_STEP4(12); SC_STEP4(16); SC_STEP4(20); SC_STEP4(24);
        SC_STEP(ca, cb, 28, 7); SC_STEP(cb, ca, 29, 7); SC_STEP(ca, cb, 30, 7);
        SC_WAIT(cb, 1); SC_MATH(cb, 31);
        ycar = rowsum16(ycar); *(LAS float*)(yo + 31 * 128) = ycar;
    };
    constexpr int NC = SEQ / TC;
    G g0, g1;
    __syncthreads();
    { const G t0 = gload(0); lwrite(0, t0); g0 = gload(1); g1 = gload(2); }
    __syncthreads();
    for (int c = 0; c < NC; c += 2) {
        compute(0); lwrite(1, g0); if (c + 3 < NC) g0 = gload(c + 3);
        __syncthreads();
        flush(c);
        compute(1); if (c + 2 < NC) { lwrite(0, g1); if (c + 4 < NC) g1 = gload(c + 4); }
        __syncthreads();
        flush(c + 1);
    }
    __syncthreads();
}

__device__ __forceinline__ const void* ldptr(volatile LAS unsigned long long* t, int i);
template <class F> __device__ __forceinline__ void conv_mat(bf16_t* dst, int N, int K, F f, long gtid, long gthreads) {
    const unsigned nlines = (unsigned)N * (unsigned)(K >> 6);
    const unsigned li0 = (unsigned)(gtid >> 3), dli = (unsigned)(gthreads >> 3), sub = (unsigned)gtid & 7u;
    unsigned n = li0 % (unsigned)N, kl = li0 / (unsigned)N;
    const unsigned dn = dli % (unsigned)N, dk = dli / (unsigned)N;
    unsigned li = li0;
    for (; li + 3u * dli < nlines; li += 4u * dli) {
        unsigned nn[4], kk[4];
#pragma unroll
        for (int q = 0; q < 4; ++q) { nn[q] = n; kk[q] = kl; n += dn; kl += dk; if (n >= (unsigned)N) { n -= (unsigned)N; ++kl; } }
        float v0[8], v1[8], v2[8], v3[8];
        f((int)nn[0], (int)(sub + 8u * kk[0]) * 8, v0); f((int)nn[1], (int)(sub + 8u * kk[1]) * 8, v1);
        f((int)nn[2], (int)(sub + 8u * kk[2]) * 8, v2); f((int)nn[3], (int)(sub + 8u * kk[3]) * 8, v3);
        *(u32x4*)(dst + (size_t)nn[0] * K + (sub + 8u * kk[0]) * 8) = pk8(v0); *(u32x4*)(dst + (size_t)nn[1] * K + (sub + 8u * kk[1]) * 8) = pk8(v1);
        *(u32x4*)(dst + (size_t)nn[2] * K + (sub + 8u * kk[2]) * 8) = pk8(v2); *(u32x4*)(dst + (size_t)nn[3] * K + (sub + 8u * kk[3]) * 8) = pk8(v3);
    }
    for (; li < nlines; li += dli) {
        const int kc = (int)(sub + 8u * kl);
        float v[8];
        f((int)n, kc * 8, v);
        *(u32x4*)(dst + (size_t)n * K + kc * 8) = pk8(v);
        n += dn; kl += dk; if (n >= (unsigned)N) { n -= (unsigned)N; ++kl; }
    }
}
typedef const __attribute__((address_space(1))) float* gfp_t;
#define GLD(p, i) (((gfp_t)(p))[(i)])
__device__ __forceinline__ void convert_region_a(volatile LAS unsigned long long* ptab, int l, long gtid, long gth) {
    unsigned char* ws = (unsigned char*)ldptr(ptab, 35);
    {
        const float* wg = ((const float*)ldptr(ptab, 3)) + (size_t)l * DM * FF; const float* wu = ((const float*)ldptr(ptab, 4)) + (size_t)l * DM * FF; const float* nr = ((const float*)ldptr(ptab, 2)) + l * DM;
        conv_mat((bf16_t*)(ws + WS_WGU1), 2 * FF, DM, [=](int n, int k0, float* v) { const int pn = n >> 8, rr = n & 255; const float* src = (rr >> 7) ? wu : wg; const int j = pn * 128 + (rr & 127);
#pragma unroll
            for (int i = 0; i < 8; ++i) v[i] = GLD(src, (size_t)(k0 + i) * FF + j) * GLD(nr, k0 + i); }, gtid, gth);
    }
    {   const float* wd = ((const float*)ldptr(ptab, 5)) + (size_t)l * FF * DM;
        conv_mat((bf16_t*)(ws + WS_WD1), DM, FF, [=](int n, int k0, float* v) {
#pragma unroll
            for (int i = 0; i < 8; ++i) v[i] = GLD(wd, (size_t)(k0 + i) * DM + n); }, gtid, gth);
    }
    {
        const float* wi = ((const float*)ldptr(ptab, 7)) + (size_t)l * DM * INW; const float* nr = ((const float*)ldptr(ptab, 6)) + l * DM;
        conv_mat((bf16_t*)(ws + WS_WIN), NU, DM, [=](int n, int k0, float* v) {
            int s; float sc = 1.f;
            if (n < 768) s = n;
            else if (n < 1024) s = 1024 + (n - 768);
            else if (n < 1280) s = 768 + (n - 1024);
            else if (n < 1536) s = n;
            else if (n < 1792) { const int j = n - 1536, c = j & 63; s = 1920 + (j & ~63) + (c >> 1) + 32 * (c & 1); }
            else if (n < 2048) s = 2688 + (n - 1792);
            else if (n < 2304) { const int j = n - 2048, c = j & 63; s = 2176 + (j & ~63) + (c >> 1) + 32 * (c & 1); sc = 0.125f; }
            else if (n < 2560) s = 2432 + (n - 2304);
            else if (n < 2944) s = 2944 + (n - 2560);
            else if (n < 3072) s = 3328 + (n - 2944);
            else if (n < 3456) s = 1536 + (n - 3072);
            else if (n < 3488) { const int c = n - 3456; s = 3456 + (c >> 1) + 16 * (c & 1); }
            else { s = 0; sc = 0.f; }
#pragma unroll
            for (int i = 0; i < 8; ++i) v[i] = GLD(wi, (size_t)(k0 + i) * INW + s) * GLD(nr, k0 + i) * sc; }, gtid, gth);
    }
    {
        const float* w2f = ((const float*)ldptr(ptab, 12)) + l * 64 * 256; const float* w2b = ((const float*)ldptr(ptab, 13)) + l * 64 * 256; const float* a2f = ((const float*)ldptr(ptab, 16)) + l * 64 * 256; const float* a2b = ((const float*)ldptr(ptab, 17)) + l * 64 * 256; const float* g2 = ((const float*)ldptr(ptab, 18)) + l * 128 * 256;
        conv_mat((bf16_t*)(ws + WS_WLORA), 1280, 384, [=](int n, int k0, float* v) {
            const int comp = n >> 8, c = n & 255; const float* src = w2f; int kr = 0; float m = 0.f;
            if (comp == 0 && k0 < 64) { src = w2f; kr = k0; m = 1.f; } else if (comp == 1 && k0 >= 64 && k0 < 128) { src = w2b; kr = k0 - 64; m = 1.f; }
            else if (comp == 2 && k0 >= 128 && k0 < 192) { src = a2f; kr = k0 - 128; m = 1.f; } else if (comp == 3 && k0 >= 192 && k0 < 256) { src = a2b; kr = k0 - 192; m = 1.f; }
            else if (comp == 4 && k0 >= 256) { src = g2; kr = k0 - 256; m = 1.f; }
#pragma unroll
            for (int i = 0; i < 8; ++i) v[i] = GLD(src, (size_t)(kr + i) * 256 + c) * m; }, gtid, gth);
    }
    {
        const float* qb = ((const float*)ldptr(ptab, 26)) + (size_t)l * 384 * 384; const float* qn = ((const float*)ldptr(ptab, 25)) + l * 384; const float* kvb = ((const float*)ldptr(ptab, 28)) + (size_t)l * 128 * 512; const float* kvn = ((const float*)ldptr(ptab, 27)) + l * 128;
        const float qscale = 0.10206207261596577f * 1.4426950408889634f;
        conv_mat((bf16_t*)(ws + WS_WMLA), 1024, 512, [=](int n, int k0, float* v) {
            const float* wp = qb; const float* np = qn; int stride = 384, col = 0, kr = 0; float m = 0.f;
            if (n < 384 && k0 < 384) { const int hh = n / 96, c = n % 96; int sc = c; if (c >= 64) { const int cc = c - 64; sc = 64 + (cc >> 1) + 16 * (cc & 1); }
                col = hh * 96 + sc; kr = k0; m = qscale; }
            else if (n >= 384 && n < 896 && k0 >= 384) { wp = kvb; np = kvn; stride = 512; col = n - 384; kr = k0 - 384; m = 1.f; }
#pragma unroll
            for (int i = 0; i < 8; ++i) v[i] = GLD(wp, (size_t)(kr + i) * stride + col) * GLD(np, kr + i) * m; }, gtid, gth);
    }
}
__device__ __forceinline__ void convert_region_b(volatile LAS unsigned long long* ptab, int l, long gtid, long gth) {
    unsigned char* ws = (unsigned char*)ldptr(ptab, 35);
    {   const float* wo = ((const float*)ldptr(ptab, 8)) + (size_t)l * DM * DM;
        conv_mat((bf16_t*)(ws + WS_WOUT), DM, DM, [=](int n, int k0, float* v) {
#pragma unroll
            for (int i = 0; i < 8; ++i) v[i] = GLD(wo, (size_t)(k0 + i) * DM + n); }, gtid, gth);
    }
    {   const float* wg = ((const float*)ldptr(ptab, 30)) + (size_t)l * DM * FF; const float* wu = ((const float*)ldptr(ptab, 31)) + (size_t)l * DM * FF; const float* nr = ((const float*)ldptr(ptab, 29)) + l * DM;
        conv_mat((bf16_t*)(ws + WS_WGU2), 2 * FF, DM, [=](int n, int k0, float* v) { const int pn = n >> 8, rr = n & 255; const float* src = (rr >> 7) ? wu : wg; const int j = pn * 128 + (rr & 127);
#pragma unroll
            for (int i = 0; i < 8; ++i) v[i] = GLD(src, (size_t)(k0 + i) * FF + j) * GLD(nr, k0 + i); }, gtid, gth);
    }
    {   const float* wd = ((const float*)ldptr(ptab, 32)) + (size_t)l * FF * DM;
        conv_mat((bf16_t*)(ws + WS_WD2), DM, FF, [=](int n, int k0, float* v) {
#pragma unroll
            for (int i = 0; i < 8; ++i) v[i] = GLD(wd, (size_t)(k0 + i) * DM + n); }, gtid, gth);
    }
}


#define XB_TMO      128
#define XB_XCNT(j)  (256  + 64 * (j))
#define XB_XSUB(j)  (1280 + 64 * (j))
#define XB_XGEN(j)  (2304 + 64 * (j))
#define XB_TOP      3328
#define XB_TOPGEN   3392
#define XCD_BAR_WORDS 3456
#define XB_SPIN_CAP (1u << 22)
__device__ __forceinline__ unsigned xb_ld(unsigned* p)              { return __hip_atomic_load(p, __ATOMIC_RELAXED, __HIP_MEMORY_SCOPE_AGENT); }
__device__ __forceinline__ unsigned xb_add(unsigned* p, unsigned v) { return __hip_atomic_fetch_add(p, v, __ATOMIC_RELAXED, __HIP_MEMORY_SCOPE_AGENT); }
__device__ __forceinline__ unsigned xb_xcc_id() { return (unsigned)__builtin_amdgcn_s_getreg((3 << 11) | 20) & 0xFu; }
#define XB_SPIN(cond, bar) do { unsigned _sp = 0; while (cond) { __builtin_amdgcn_s_sleep(1); \
    if ((++_sp & 255u) == 0u) { if (xb_ld(&(bar)[XB_TMO])) break; if (_sp > XB_SPIN_CAP) { atomicAdd(&(bar)[XB_TMO], 1u); break; } } } } while (0)
struct XcdBarrier { unsigned* bar; unsigned x; volatile LAS unsigned* st; };
__device__ __forceinline__ XcdBarrier xcd_barrier_post(unsigned* bar, volatile LAS unsigned* st) {
    XcdBarrier b; b.bar = bar; b.x = xb_xcc_id(); b.st = st;
    if (threadIdx.x == 0) (void)xb_add(&bar[XB_XCNT(b.x)], 1u);
    return b;
}
__device__ __forceinline__ void xcd_barrier_complete(unsigned* bar, unsigned x, unsigned& nloc, unsigned& nx) {
    const unsigned G = gridDim.x * gridDim.y * gridDim.z;
    unsigned sum, cnt, mine, sp = 0u;
    for (;;) {
        sum = 0u; cnt = 0u; mine = 0u;
#pragma unroll
        for (unsigned j = 0; j < 16; ++j) { const unsigned c = xb_ld(&bar[XB_XCNT(j)]); sum += c; cnt += (c > 0u) ? 1u : 0u; mine = (j == x) ? c : mine; }
        if (sum == G) break;
        __builtin_amdgcn_s_sleep(1);
        if ((++sp & 255u) == 0u) { if (xb_ld(&bar[XB_TMO])) break; if (sp > XB_SPIN_CAP) { atomicAdd(&bar[XB_TMO], 1u); break; } }
    }
    nloc = mine > 0u ? mine : 1u; nx = cnt > 0u ? cnt : 1u;
}
__device__ __forceinline__ void xcd_barrier(const XcdBarrier& b) {
    asm volatile("s_waitcnt vmcnt(0)" ::: "memory");
    __syncthreads();
    if (threadIdx.x == 0) {
        unsigned* bar = b.bar;
        __builtin_amdgcn_s_waitcnt(0);
        unsigned nloc = b.st[0], nx = b.st[1];
        if (nloc == 0u) { xcd_barrier_complete(bar, b.x, nloc, nx); b.st[0] = nloc; b.st[1] = nx; }
        const unsigned old = xb_add(&bar[XB_XSUB(b.x)], 1u);
        const unsigned gen = old / nloc;
        if (old + 1u == (gen + 1u) * nloc) {
            __builtin_amdgcn_fence(__ATOMIC_RELEASE, "agent");
            asm volatile("s_waitcnt vmcnt(0)" ::: "memory");
            const unsigned og = xb_add(&bar[XB_TOP], 1u);
            const unsigned tg = og / nx;
            if (og + 1u == (tg + 1u) * nx) xb_add(&bar[XB_TOPGEN], 1u);
            else XB_SPIN(xb_ld(&bar[XB_TOPGEN]) == tg, bar);
            __builtin_amdgcn_fence(__ATOMIC_ACQUIRE, "agent");
            xb_add(&bar[XB_XGEN(b.x)], 1u);
            asm volatile("s_waitcnt vmcnt(0)" ::: "memory");
        } else {
            XB_SPIN(xb_ld(&bar[XB_XGEN(b.x)]) == gen, bar);
            __builtin_amdgcn_fence(__ATOMIC_ACQUIRE, "agent");
            asm volatile("s_waitcnt vmcnt(0)" ::: "memory");
        }
    }
    __syncthreads();
}

constexpr int PTAB_OFF = 143360;
__device__ __forceinline__ const void* ldptr(volatile LAS unsigned long long* t, int i) {
    const unsigned long long v = t[i];
    const unsigned lo = __builtin_amdgcn_readfirstlane((unsigned)v), hi = __builtin_amdgcn_readfirstlane((unsigned)(v >> 32));
    return (const void*)(const __attribute__((address_space(1))) void*)(((unsigned long long)hi << 32) | lo);
}
#ifndef PHMASK
#define PHMASK 0xFFFF
#endif
#define PHON(i) ((PHMASK >> (i)) & 1)
#ifndef REPMASK
#define REPMASK 0
#endif
#define NREP(i) (((REPMASK >> (i)) & 1) ? 2 : 1)
__global__ void __launch_bounds__(512, 2) fwd_kernel(Args a) {
    extern __shared__ __attribute__((aligned(16))) unsigned char smem_raw[];
    LAS unsigned char* lds = (LAS unsigned char*)smem_raw;
    cg::grid_group grid = cg::this_grid();
    const int nb = gridDim.x, bid = blockIdx.x;
    volatile LAS unsigned long long* ptab = (volatile LAS unsigned long long*)(lds + PTAB_OFF);
    if (threadIdx.x == 0) {
#pragma unroll
        for (int i = 0; i < 34; ++i) ptab[i] = (unsigned long long)a.in[i];
        ptab[34] = (unsigned long long)a.out; ptab[35] = (unsigned long long)a.ws;
        ((volatile LAS unsigned*)(lds + PTAB_OFF + 512))[0] = 0u; ((volatile LAS unsigned*)(lds + PTAB_OFF + 512))[1] = 0u;
    }
    __syncthreads();
    { const XcdBarrier xb0 = xcd_barrier_post((unsigned*)a.ws, (volatile LAS unsigned*)(lds + PTAB_OFF + 512)); if (threadIdx.x == 0) ((volatile LAS unsigned*)(lds + PTAB_OFF + 512))[2] = xb0.x; }
    __syncthreads();
    const int ph_lo = a.ph_lo, ph_hi = a.ph_hi;
#define INP(i) ((const float*)ldptr(ptab, (i)))

    for (int ph = ph_lo; ph < ph_hi; ++ph) {
        unsigned char* ws = (unsigned char*)ldptr(ptab, 35);
        float* const outp = (float*)ldptr(ptab, 34);
        const int* pos = (const int*)INP(1);
        int tid = threadIdx.x; asm volatile("" : "+v"(tid));
        const int wid = tid >> 6, lane = tid & 63;
        const long gtid = (long)bid * 512 + tid, gth = (long)nb * 512;
        float* ssq = (float*)(ws + WS_SSQP);
        float* sqq = (float*)(ws + WS_SQQ); float* sqkv = (float*)(ws + WS_SQKV);
#define SSQI(i) (ssq + (size_t)((i) & 1) * MTOK * 16)
        bf16_t* XB = (bf16_t*)(ws + WS_XB); bf16_t* U = (bf16_t*)(ws + WS_U);
        if (PHON(0) && ph == 0) {
          for (int rep = 0; rep < NREP(0); ++rep) {
            for (int row = bid * 8 + wid; row < MTOK; row += nb * 8) {
                const float* xr = INP(0) + (size_t)row * DM; float sq = 0.f;
#pragma unroll
                for (int i = 0; i < 2; ++i) {
                    const int c = i * 512 + lane * 8;
                    const f32x4 x0 = *(const f32x4*)(xr + c), x1 = *(const f32x4*)(xr + c + 4);
                    float v[8] = {x0[0], x0[1], x0[2], x0[3], x1[0], x1[1], x1[2], x1[3]};
#pragma unroll
                    for (int j = 0; j < 8; ++j) sq += v[j] * v[j];
                    *(u32x4*)(XB + (size_t)row * DM + c) = pk8(v);
                }
                sq = wavesum(sq);
                if (lane == 0) { float* sp = ssq + (size_t)row * 16; *(f32x4*)sp = (f32x4){sq, 0.f, 0.f, 0.f}; *(f32x4*)(sp + 4) = (f32x4){0.f, 0.f, 0.f, 0.f}; *(f32x4*)(sp + 8) = (f32x4){0.f, 0.f, 0.f, 0.f}; *(f32x4*)(sp + 12) = (f32x4){0.f, 0.f, 0.f, 0.f}; }
            }
            convert_region_a(ptab, 0, gtid, gth);
            if (nb < 256) convert_region_b(ptab, 0, gtid, gth);
          }
        } else if (PHON(1) && ph == 19) {
            const float* fg = INP(33);
            for (int row = bid * 8 + wid; row < MTOK; row += nb * 8) {
                float* xr = outp + (size_t)row * DM;
                f32x4 xv[4]; float sq = 0.f;
#pragma unroll
                for (int i = 0; i < 4; ++i) { xv[i] = *(const f32x4*)(xr + i * 256 + lane * 4); sq += xv[i][0] * xv[i][0] + xv[i][1] * xv[i][1] + xv[i][2] * xv[i][2] + xv[i][3] * xv[i][3]; }
                sq = wavesum(sq);
                const float rs = rsqrtf(sq * (1.0f / DM) + NEPS);
#pragma unroll
                for (int i = 0; i < 4; ++i) { const int c = i * 256 + lane * 4; const f32x4 g = *(const f32x4*)(fg + c); *(f32x4*)(xr + c) = xv[i] * rs * g; }
            }
        } else {
            const int l = (ph - 1) / 9, k = (ph - 1) % 9;
            pg8::StaticOrder S;
            if (PHON(2) && (k == 0 || k == 7)) {
                const int f2 = (k == 7);
                pg8::Gemm g{XB, (const bf16_t*)(ws + (f2 ? WS_WGU2 : WS_WGU1)), MTOK, 2 * FF, DM, DM, 512};
                pg8::EpiGU E{SSQI(3 * l + (f2 ? 2 : 0)), U};
                S.init(MTOK, 2 * FF, nb, bid);
                for (int rep = 0; rep < NREP(1); ++rep) pg8::gemm_phase(lds, g, S, E, tid);
            } else if (PHON(3) && (k == 1 || k == 8 || k == 6)) {
                pg8::Gemm g; pg8::EpiRes E;
                if (k == 6) { g = pg8::Gemm{U + U_CB, (const bf16_t*)(ws + WS_WOUT), MTOK, DM, DM, NU, 768 * 2}; E = pg8::EpiRes{outp, outp, XB, SSQI(3 * l + 2), 1.0f, 0}; }
                else { const int f2 = (k == 8);
                    g = pg8::Gemm{U, (const bf16_t*)(ws + (f2 ? WS_WD2 : WS_WD1)), MTOK, DM, FF, FF, 512};
                    E = pg8::EpiRes{(l == 0 && !f2) ? INP(0) : outp, outp, XB, SSQI(3 * l + (f2 ? 3 : 1)), 0.5f, 0}; }
                S.init(MTOK, DM, nb, bid);
                { const int nr = (k == 6) ? NREP(9) : NREP(8); for (int rep = 0; rep < nr; ++rep) { E.dry = (rep + 1 < nr) ? 1 : ((k == 8 && l == 1) ? -1 : 0); pg8::gemm_phase(lds, g, S, E, tid); } }
            } else if (PHON(4) && k == 2) {
                pg8::Gemm g{XB, (const bf16_t*)(ws + WS_WIN), MTOK, NU, DM, DM, 512};
                pg8::EpiWin E{SSQI(3 * l + 1), pos, U, sqq, sqkv, (bf16_t*)(ws + WS_KR), (bf16_t*)(ws + WS_VTR)};
                S.init(MTOK, NU, nb, bid);
                for (int rep = 0; rep < NREP(2); ++rep) pg8::gemm_phase(lds, g, S, E, tid);
            } else if (PHON(5) && k == 3) {
                if (PHON(8)) {   pg8::Gemm g{U + U_LORA, (const bf16_t*)(ws + WS_WLORA), MTOK, 1280, 384, NU, 512};
                    pg8::EpiLora E{ws, INP(10) + l * 256, INP(11) + l * 256, INP(14) + l * 256, INP(15) + l * 256};
                    S.init(MTOK, 1280, nb, bid);
                    for (int rep = 0; rep < NREP(3); ++rep) pg8::gemm_phase(lds, g, S, E, tid); }
                if (PHON(9)) {   pg8::Gemm g{U + U_QA, (const bf16_t*)(ws + WS_WMLA), MTOK, 1024, 512, NU, 512};
                    pg8::EpiMla E{sqq, sqkv, pos, (bf16_t*)(ws + WS_QM), (bf16_t*)(ws + WS_KN), (bf16_t*)(ws + WS_VTM)};
                    S.init(MTOK, 1024, nb, bid);
                    for (int rep = 0; rep < NREP(3); ++rep) pg8::gemm_phase(lds, g, S, E, tid); }
                if (PHON(10)) {
                    const float* cw = INP(9) + l * 768;
                    for (int rep = 0; rep < NREP(6); ++rep)
                    for (long it = gtid; it < (long)MTOK * 32; it += gth) {
                        const int tok = (int)(it >> 5), c8 = (int)(it & 31) * 8, t = tok & (SEQ - 1);
                        float acc8[8] = {0.f, 0.f, 0.f, 0.f, 0.f, 0.f, 0.f, 0.f};
#pragma unroll
                        for (int j = 0; j < 3; ++j) {
                            const int tt = t + j - 1;
                            if (tt >= 0 && tt < SEQ) {
                                const bf16_t* ur = U + (size_t)(tok + j - 1) * NU;
                                float cx[8], cc[8]; unpk8(*(const u32x4*)(ur + U_CX + c8), cx); unpk8(*(const u32x4*)(ur + U_CC + c8), cc);
#pragma unroll
                                for (int i = 0; i < 8; ++i) acc8[i] += cw[j * 256 + c8 + i] * (cx[i] * cc[i]);
                            }
                        }
                        bf16_t* bp = U + (size_t)tok * NU + U_CB + c8; float cb[8]; unpk8(*(const u32x4*)bp, cb);
#pragma unroll
                        for (int i = 0; i < 8; ++i) acc8[i] *= cb[i];
                        *(u32x4*)(rep + 1 < NREP(6) ? U + (size_t)tok * NU + U_TV + c8 : bp) = pk8(acc8);
                    }
                }
            } else if (PHON(6) && k == 4) {
                for (int rep = 0; rep < NREP(4); ++rep) for (int sx = bid; sx < 128; sx += nb) rwkv_scan(lds, ws, INP(19) + l * 256, INP(20) + l * 256, sx, tid);
                for (int rep = 0; rep < NREP(5); ++rep) {
                    unsigned* ctr = (unsigned*)ws + 3600 + l + 2 * rep;
                    volatile LAS unsigned* uw = (volatile LAS unsigned*)(lds + PTAB_OFF + 640);
                    const float* gng = INP(24) + l * 256;
                    const int ocol = (rep + 1 < NREP(5)) ? U_TV : U_TG;
                    for (;;) {
                        __syncthreads();
                        if (tid == 0) *uw = atomicAdd(ctr, 1u);
                        __syncthreads();
                        const int unit = __builtin_amdgcn_readfirstlane(*uw);
                        if (unit >= 512) break;
                        if (unit < 256) attn_unit<0>(lds, ws, nullptr, unit, tid); else attn_unit<1>(lds, ws, gng, unit - 256, tid, ocol);
                    }
                }
                if (nb >= 256 && bid >= 128) {
                    const long g2 = (long)(bid - 128) * 512 + tid, gt2 = (long)128 * 512;
                    if (l == 0) { convert_region_b(ptab, 0, g2, gt2); convert_region_a(ptab, 1, g2, gt2); } else convert_region_b(ptab, 1, g2, gt2);
                } else if (nb < 256) { if (l == 0) convert_region_a(ptab, 1, gtid, gth); else convert_region_b(ptab, 1, gtid, gth); }
            } else if (PHON(7) && k == 5) {
                const bf16_t* YF = (const bf16_t*)(ws + WS_YF); const bf16_t* YB = (const bf16_t*)(ws + WS_YB);
                const bf16_t* AF = (const bf16_t*)(ws + WS_AF); const bf16_t* AB = (const bf16_t*)(ws + WS_AB); const bf16_t* GG = (const bf16_t*)(ws + WS_GG);
                const float* k_a = INP(20) + l * 256; const float* r_k = INP(21) + l * 256; const float* lg = INP(22) + l * 256; const float* lb = INP(23) + l * 256;
                for (int rep = 0; rep < NREP(7); ++rep)
                for (int gidx = bid * 32 + (tid >> 4); gidx < MTOK * 4; gidx += nb * 32) {
                    const int tok = gidx >> 2, h = gidx & 3, ch = h * 64 + 4 * (tid & 15);
                    const size_t lr = (size_t)tok * 256 + ch; bf16_t* ur = U + (size_t)tok * NU;
                    const u32x2 wf = *(const u32x2*)(YF + lr), wb = *(const u32x2*)(YB + lr);
                    f32x4 y = {bflo(wf.x) + bflo(wb.x), bfhi(wf.x) + bfhi(wb.x), bflo(wf.y) + bflo(wb.y), bfhi(wf.y) + bfhi(wb.y)};
                    const float mu = rowsum16(y[0] + y[1] + y[2] + y[3]) * (1.0f / 64.0f);
                    const f32x4 d = y - mu;
                    const float var = rowsum16(d[0] * d[0] + d[1] * d[1] + d[2] * d[2] + d[3] * d[3]) * (1.0f / 64.0f);
                    const float rsd = rsqrtf(var + 64e-5f);
                    const u32x2 wr_ = *(const u32x2*)(ur + U_RR + ch), wk_ = *(const u32x2*)(ur + U_RK + ch), wv_ = *(const u32x2*)(ur + U_RV + ch);
                    const u32x2 waf = *(const u32x2*)(AF + lr), wab = *(const u32x2*)(AB + lr), wg_ = *(const u32x2*)(GG + lr);
                    const f32x4 r4 = {bflo(wr_.x), bfhi(wr_.x), bflo(wr_.y), bfhi(wr_.y)}, k4 = {bflo(wk_.x), bfhi(wk_.x), bflo(wk_.y), bfhi(wk_.y)}, v4 = {bflo(wv_.x), bfhi(wv_.x), bflo(wv_.y), bfhi(wv_.y)};
                    const f32x4 af = {bflo(waf.x), bfhi(waf.x), bflo(waf.y), bfhi(waf.y)}, ab = {bflo(wab.x), bfhi(wab.x), bflo(wab.y), bfhi(wab.y)}, g4 = {bflo(wg_.x), bfhi(wg_.x), bflo(wg_.y), bfhi(wg_.y)};
                    const f32x4 ka = *(const f32x4*)(k_a + ch), rk = *(const f32x4*)(r_k + ch), lg4 = *(const f32x4*)(lg + ch), lb4 = *(const f32x4*)(lb + ch);
                    const f32x4 ksum = k4 * (2.0f + (af + ab - 2.0f) * ka);
                    const f32x4 pr = r4 * ksum * rk;
                    const float bs = rowsum16(pr[0] + pr[1] + pr[2] + pr[3]);
                    const f32x4 o = (d * rsd * lg4 + lb4 + bs * v4) * g4;
                    u32x2 w; w.x = pk2(o[0], o[1]); w.y = pk2(o[2], o[3]);
                    *(u32x2*)(ur + (rep + 1 < NREP(7) ? U_TV : U_RR) + ch) = w;
                }

            }
        }
        if (ph + 1 < ph_hi) {
            if (ph_hi > 1000) grid.sync();
            { XcdBarrier xb; xb.st = (volatile LAS unsigned*)(lds + PTAB_OFF + 512); xb.bar = (unsigned*)ldptr(ptab, 35); xb.x = __builtin_amdgcn_readfirstlane(xb.st[2]); xcd_barrier(xb); if (NREP(10) > 1) { xcd_barrier(xb); xcd_barrier(xb); } }
        }
    }
}

#ifndef RUNMASK
#define RUNMASK 0xFFFFF
#endif
#ifndef MK_MULTI
#define MK_MULTI 0
#endif
extern "C" void kernel_launch(void* const* d_in, const int* in_sizes, int n_in, void* d_out, int out_size, void* d_ws, size_t ws_size, hipStream_t stream) {
    static int grid = 0;
    if (grid == 0) {
        if (n_in != 34 || ws_size < WS_END) { fprintf(stderr, "kernel_launch: unexpected n_in %d / ws %zu\n", n_in, ws_size); grid = -1; return; }
        if (hipFuncSetAttribute((const void*)fwd_kernel, hipFuncAttributeMaxDynamicSharedMemorySize, LDS_BYTES) != hipSuccess) { fprintf(stderr, "hipFuncSetAttribute failed\n"); grid = -1; return; }
        int dev = 0, cus = 0, per_cu = 0;
        hipGetDevice(&dev); hipDeviceGetAttribute(&cus, hipDeviceAttributeMultiprocessorCount, dev);
        hipOccupancyMaxActiveBlocksPerMultiprocessor(&per_cu, (const void*)fwd_kernel, 512, LDS_BYTES);
        (void)hipGetLastError();
        if (per_cu < 1) fprintf(stderr, "occupancy query says %d blocks per CU\n", per_cu);
        grid = cus > 0 ? cus : 256;
    }
    if (grid < 0) return;
    Args a{};
    for (int i = 0; i < 34; ++i) a.in[i] = (const float*)d_in[i];
    a.out = (float*)d_out; a.ws = (unsigned char*)d_ws;
    if (hipMemsetAsync(d_ws, 0, 16384, stream) != hipSuccess) { fprintf(stderr, "memset failed\n"); return; }
#if MK_MULTI
    for (int p = 0; p < 20; ++p) { if (!((RUNMASK >> p) & 1)) continue; a.ph_lo = p; a.ph_hi = p + 1; hipLaunchKernelGGL(fwd_kernel, dim3(grid), dim3(512), LDS_BYTES, stream, a); }
#else
    a.ph_lo = 0; a.ph_hi = 20;
    void* args[] = {&a};
    hipError_t e = hipLaunchCooperativeKernel((const void*)fwd_kernel, dim3(grid), dim3(512), args, LDS_BYTES, stream);
    if (e != hipSuccess) fprintf(stderr, "cooperative launch failed: %s (grid %d)\n", hipGetErrorString(e), grid);
#endif
}
```

```cpp
#include <hip/hip_runtime.h>
#include <hip/hip_cooperative_groups.h>
#include <cstdint>
#include <cstdio>
namespace cg = cooperative_groups;

#define LAS __attribute__((address_space(3)))
typedef unsigned short bf16_t;
typedef short bf16x8 __attribute__((ext_vector_type(8)));
typedef short s16x4 __attribute__((ext_vector_type(4)));
typedef float f32x4 __attribute__((ext_vector_type(4)));
typedef float f32x16 __attribute__((ext_vector_type(16)));
typedef float f32x2 __attribute__((ext_vector_type(2)));
typedef unsigned u32x4 __attribute__((ext_vector_type(4)));
typedef unsigned u32x2 __attribute__((ext_vector_type(2)));

constexpr int MTOK = 16384, SEQ = 2048, DM = 1024, FF = 2816, NU = 3584, INW = 3488;
constexpr float NEPS = 1e-6f;
constexpr int U_CX = 0, U_CB = 256, U_CC = 512, U_RK = 768, U_RR = 1024, U_RV = 1280, U_TQ = 1536, U_TG = 1792, U_TK = 2048,
              U_TV = 2304, U_QA = 2560, U_CKV = 2944, U_LORA = 3072, U_KR = 3456;
constexpr size_t MiB = 1u << 20;
constexpr size_t WS_SSQ = 0;
constexpr size_t WS_WGU1 = 1 * MiB, WS_WD1 = 12 * MiB, WS_WIN = 17 * MiB + 512 * 1024, WS_WLORA = 24 * MiB + 512 * 1024, WS_WMLA = 25 * MiB + 512 * 1024;
constexpr size_t WS_WOUT = 27 * MiB, WS_WGU2 = 29 * MiB, WS_WD2 = 40 * MiB;
constexpr size_t WS_XB = 46 * MiB;
constexpr size_t WS_YF = 46 * MiB, WS_YB = 54 * MiB, WS_AB = 62 * MiB, WS_GG = 70 * MiB;
constexpr size_t WS_U = 78 * MiB;
constexpr size_t WS_EF = 190 * MiB, WS_EB = 198 * MiB, WS_AF = 206 * MiB;
constexpr size_t WS_QM = 214 * MiB, WS_KN = 226 * MiB, WS_KR = 234 * MiB, WS_VTM = 235 * MiB, WS_VTR = 243 * MiB, WS_END = 255 * MiB;
constexpr size_t WS_SSQP = 251 * MiB, WS_SQQ = 253 * MiB, WS_SQKV = 254 * MiB;
constexpr int LDS_BYTES = 147456;

struct Args { const float* in[34]; float* out; unsigned char* ws; int ph_lo, ph_hi; };

__device__ __forceinline__ unsigned f2bf(float f) { unsigned u = __float_as_uint(f); return (u + 0x7fffu + ((u >> 16) & 1u)) >> 16; }
typedef __bf16 hwbf16x2 __attribute__((ext_vector_type(2)));
__device__ __forceinline__ unsigned pk2(float lo, float hi) { const f32x2 v = {lo, hi}; return __builtin_bit_cast(unsigned, __builtin_convertvector(v, hwbf16x2)); }
__device__ __forceinline__ float bflo(unsigned w) { return __uint_as_float(w << 16); }
__device__ __forceinline__ float bfhi(unsigned w) { return __uint_as_float(w & 0xffff0000u); }
__device__ __forceinline__ u32x4 pk8(const float* v) { u32x4 w; w.x = pk2(v[0], v[1]); w.y = pk2(v[2], v[3]); w.z = pk2(v[4], v[5]); w.w = pk2(v[6], v[7]); return w; }
__device__ __forceinline__ void unpk8(u32x4 w, float* v) { v[0] = bflo(w.x); v[1] = bfhi(w.x); v[2] = bflo(w.y); v[3] = bfhi(w.y); v[4] = bflo(w.z); v[5] = bfhi(w.z); v[6] = bflo(w.w); v[7] = bfhi(w.w); }
__device__ __forceinline__ float sigmoidf_(float x) { return __builtin_amdgcn_rcpf(1.0f + __expf(-x)); }
template <int CTRL> __device__ __forceinline__ float dppf(float x) { return __int_as_float(__builtin_amdgcn_update_dpp(0, __float_as_int(x), CTRL, 0xF, 0xF, true)); }
__device__ __forceinline__ float rowsum16(float x) { x += dppf<0xB1>(x); x += dppf<0x4E>(x); x += dppf<0x124>(x); x += dppf<0x128>(x); return x; }
__device__ __forceinline__ float wavesum(float v) { for (int o = 32; o > 0; o >>= 1) v += __shfl_xor(v, o); return v; }
__device__ __forceinline__ float sum16(const float* p) { const f32x4 a = *(const f32x4*)p, b = *(const f32x4*)(p + 4), c = *(const f32x4*)(p + 8), d = *(const f32x4*)(p + 12);
    return (((a[0] + a[1]) + (a[2] + a[3])) + ((b[0] + b[1]) + (b[2] + b[3]))) + (((c[0] + c[1]) + (c[2] + c[3])) + ((d[0] + d[1]) + (d[2] + d[3]))); }
__device__ __forceinline__ float sum12(const float* p) { const f32x4 a = *(const f32x4*)p, b = *(const f32x4*)(p + 4), c = *(const f32x4*)(p + 8);
    return (((a[0] + a[1]) + (a[2] + a[3])) + ((b[0] + b[1]) + (b[2] + b[3]))) + ((c[0] + c[1]) + (c[2] + c[3])); }
__device__ __forceinline__ float sum4(const float* p) { const f32x4 a = *(const f32x4*)p; return (a[0] + a[1]) + (a[2] + a[3]); }
__device__ __forceinline__ float xfq(float v) { v += __shfl_xor(v, 16); v += __shfl_xor(v, 32); return v; }
__device__ __forceinline__ void rope_cs(int p, float inv, float& c, float& s) {
    const float ang = (float)p * inv; const float rev = ang * 0.15915494309189535f; const float fr = rev - floorf(rev);
    c = __builtin_amdgcn_cosf(fr); s = __builtin_amdgcn_sinf(fr);
}

namespace pg8 {
constexpr int BM = 256, BK = 64, HALF = 128, HTB = HALF * BK * 2, NXCD = 8, WGM = 8;
__host__ __device__ __forceinline__ int lds_byte(int r, int c) { const int st = (r >> 4) * 2 + (c >> 5), rr = r & 15, cc = c & 31, ob = rr * 64 + cc * 2; return st * 1024 + (ob ^ (((ob >> 9) & 1) << 5)); }
__host__ __device__ __forceinline__ void stage_rc(int b, int& R, int& C) { const int st = b / 1024, sb = b % 1024, swz = sb ^ (((sb >> 9) & 1) << 5); R = (st >> 1) * 16 + swz / 64; C = (st & 1) * 32 + (swz % 64) / 2; }
__host__ __device__ __forceinline__ int perm32(int rho) { const int n = rho >> 4, i = rho & 15; return 8 * (i >> 2) + 4 * n + (i & 3); }
struct Unit { int pm, pn; };
struct Gemm { const bf16_t* A; const bf16_t* Bt; int M, N, K, lda, kseg; };
struct StaticOrder {
    int nM, nN, nwg, G, c;
    __device__ void init(int M, int N, int G_, int c_) { nM = M / BM; nN = N / BM; nwg = nM * nN; G = G_; c = c_; }
    __device__ bool next(int i, Unit& u) const {
        const long L = (long)i * G + c; if (L >= nwg) return false;
        int wgid = (int)L; { const int q = nwg / NXCD, r = nwg % NXCD, xcd = wgid % NXCD, off = wgid / NXCD; wgid = (xcd < r ? xcd * (q + 1) : r * (q + 1) + (xcd - r) * q) + off; }
        const int nig = WGM * nN, gid = wgid / nig, fm = gid * WGM, gsz = (nM - fm) < WGM ? (nM - fm) : WGM;
        u.pm = fm + ((wgid % nig) % gsz); u.pn = (wgid % nig) / gsz; return true;
    }
};
template <class Epi, class Sched>
__device__ __forceinline__ void gemm_phase(LAS unsigned char* lds, const Gemm g, const Sched& S, const Epi& E, const int tid) {
    const int wid = __builtin_amdgcn_readfirstlane(tid >> 6), lane = tid & 63, wr = wid >> 2, wc = wid & 3, fr = lane & 15, fq = lane >> 4;
    const int K = g.K, nt = K / BK;
    unsigned voffA[2], voffB[2];
#pragma unroll
    for (int i = 0; i < 2; ++i) { int R, C; stage_rc(tid * 16 + i * 8192, R, C); const int Rb = (R & ~31) + perm32(R & 31);
        voffA[i] = (unsigned)(R * g.lda + C) * 2u; voffB[i] = (unsigned)(Rb * K + C) * 2u; }
    const size_t kstep = (size_t)(BK * 2);
    const size_t hstepA = (size_t)HALF * g.lda * 2, tstepA = 2 * hstepA;
    const size_t hstepB = (size_t)HALF * K * 2, tstepB = 2 * hstepB;
    const size_t kseg = (size_t)g.kseg;
    const unsigned ldsw = (unsigned)wid * 1024u;
    const int aoff = lds_byte(wr * 64 + fr, fq * 8), boff = lds_byte(wc * 32 + fr, fq * 8);
#define KOFFA(t) ((size_t)((t) >> 2) * kseg + (size_t)((t) & 3) * kstep)
#define PG8_SA(b, h) (((b) * 2 + (h)) * HTB)
#define PG8_SB(b, h) ((4 + (b) * 2 + (h)) * HTB)
#define PG8_STAGE(bufoff, gbase, voff) do { _Pragma("unroll") for (int _i = 0; _i < 2; ++_i) { unsigned _vo = (voff)[_i]; asm volatile("" : "+v"(_vo)); \
        __builtin_amdgcn_global_load_lds((const unsigned*)((const char*)(gbase) + _vo), (LAS unsigned*)(lds + (bufoff) + ldsw + _i * 8192), 16, 0, 0); } } while (0)
#define PG8_LDA(dst, b, h) do { _Pragma("unroll") for (int m = 0; m < 4; ++m) _Pragma("unroll") for (int k = 0; k < 2; ++k) dst[m][k] = *(const LAS bf16x8*)(lds + PG8_SA(b, h) + aoff + m * 2048 + k * 1024); } while (0)
#define PG8_LDB(dst, b, h) do { _Pragma("unroll") for (int n = 0; n < 2; ++n) _Pragma("unroll") for (int k = 0; k < 2; ++k) dst[n][k] = *(const LAS bf16x8*)(lds + PG8_SB(b, h) + boff + n * 2048 + k * 1024); } while (0)
#define PG8_MMA(ai, bj, At, Bt) do { __builtin_amdgcn_s_setprio(1); _Pragma("unroll") for (int m = 0; m < 4; ++m) _Pragma("unroll") for (int n = 0; n < 2; ++n) _Pragma("unroll") for (int k = 0; k < 2; ++k) \
        acc[ai][bj][m][n] = __builtin_amdgcn_mfma_f32_16x16x32_bf16(Bt[n][k], At[m][k], acc[ai][bj][m][n], 0, 0, 0); __builtin_amdgcn_s_setprio(0); } while (0)
#define PG8_WAIT_V(n) asm volatile("s_waitcnt vmcnt(" #n ")" ::: "memory")
#define PG8_WAIT_L(n) asm volatile("s_waitcnt lgkmcnt(" #n ")" ::: "memory")
#define PG8_BAR __builtin_amdgcn_s_barrier()
#define PG8_SCHED __builtin_amdgcn_sched_barrier(0)
    Unit cur, nxt; int ui = 0;
    if (!S.next(0, cur)) return;
    f32x4 acc[2][2][4][2];
#pragma unroll
    for (int a = 0; a < 2; ++a)
#pragma unroll
        for (int b = 0; b < 2; ++b)
#pragma unroll
            for (int m = 0; m < 4; ++m)
#pragma unroll
                for (int n = 0; n < 2; ++n) acc[a][b][m][n] = (f32x4){0.f, 0.f, 0.f, 0.f};
    bf16x8 At[4][2], B0[2][2], B1[2][2];
    const char* cA = (const char*)g.A + (size_t)cur.pm * tstepA; const char* cB = (const char*)g.Bt + (size_t)cur.pn * tstepB;
    PG8_STAGE(PG8_SB(0, 0), cB, voffB); PG8_STAGE(PG8_SB(0, 1), cB + hstepB, voffB); PG8_STAGE(PG8_SA(0, 0), cA, voffA); PG8_STAGE(PG8_SA(0, 1), cA + hstepA, voffA);
    if (wr == 1) PG8_BAR;
    PG8_WAIT_V(2); PG8_BAR;
    PG8_STAGE(PG8_SB(1, 0), cB + kstep, voffB); PG8_STAGE(PG8_SA(1, 0), cA + KOFFA(1), voffA); PG8_STAGE(PG8_SB(1, 1), cB + hstepB + kstep, voffB);
    PG8_WAIT_V(6); PG8_BAR;
    for (;;) {
        const bool has_next = S.next(ui + 1, nxt);
        const char* nA = has_next ? (const char*)g.A + (size_t)nxt.pm * tstepA : cA; const char* nB = has_next ? (const char*)g.Bt + (size_t)nxt.pn * tstepB : cB;
#pragma unroll 1
        for (int t = 0; t < nt; t += 2) {
            const bool last = (t == nt - 2);
            const char* a1 = cA + KOFFA(t + 1);
            const char* a2 = last ? nA : cA + KOFFA(t + 2); const char* b2 = last ? nB : cB + (size_t)(t + 2) * kstep;
            const char* a3 = last ? nA + KOFFA(1) : cA + KOFFA(t + 3); const char* b3 = b2 + kstep;
            PG8_LDB(B0, 0, 0); PG8_LDB(B1, 0, 1); PG8_SCHED; PG8_LDA(At, 0, 0); PG8_STAGE(PG8_SA(1, 1), a1 + hstepA, voffA);
            PG8_WAIT_V(8); PG8_WAIT_L(0); PG8_BAR; PG8_MMA(0, 0, At, B0); PG8_MMA(0, 1, At, B1); PG8_BAR; PG8_SCHED;
            PG8_LDA(At, 0, 1); PG8_STAGE(PG8_SB(0, 0), b2, voffB); PG8_STAGE(PG8_SB(0, 1), b2 + hstepB, voffB); PG8_STAGE(PG8_SA(0, 0), a2, voffA);
            PG8_WAIT_V(8); PG8_WAIT_L(0); PG8_BAR; PG8_MMA(1, 0, At, B0); PG8_MMA(1, 1, At, B1); PG8_BAR; PG8_SCHED;
            PG8_LDB(B0, 1, 0); PG8_LDB(B1, 1, 1); PG8_SCHED; PG8_LDA(At, 1, 0); PG8_STAGE(PG8_SA(0, 1), a2 + hstepA, voffA);
            PG8_WAIT_V(8); PG8_WAIT_L(0); PG8_BAR; PG8_MMA(0, 0, At, B0); PG8_MMA(0, 1, At, B1); PG8_BAR; PG8_SCHED;
            PG8_LDA(At, 1, 1); PG8_STAGE(PG8_SB(1, 0), b3, voffB); PG8_STAGE(PG8_SB(1, 1), b3 + hstepB, voffB); PG8_STAGE(PG8_SA(1, 0), a3, voffA);
            PG8_WAIT_V(8); PG8_WAIT_L(0); PG8_BAR; PG8_MMA(1, 0, At, B0); PG8_MMA(1, 1, At, B1); PG8_BAR; PG8_SCHED;
        }
        if (wr == 0) PG8_BAR;
        E(acc, cur, wr, wc, fr, fq);
        if (!has_next) break;
#pragma unroll
        for (int a = 0; a < 2; ++a)
#pragma unroll
            for (int b = 0; b < 2; ++b)
#pragma unroll
                for (int m = 0; m < 4; ++m)
#pragma unroll
                    for (int n = 0; n < 2; ++n) acc[a][b][m][n] = (f32x4){0.f, 0.f, 0.f, 0.f};
        cur = nxt; cA = nA; cB = nB; ++ui;
        if (wr == 1) PG8_BAR;
    }
    PG8_WAIT_V(0);
    PG8_BAR;
#undef KOFFA
#undef PG8_SA
#undef PG8_SB
#undef PG8_STAGE
#undef PG8_LDA
#undef PG8_LDB
#undef PG8_MMA
#undef PG8_WAIT_V
#undef PG8_WAIT_L
#undef PG8_BAR
#undef PG8_SCHED
}
typedef f32x4 Acc[2][2][4][2];

struct EpiGU {
    const float* ssq; bf16_t* H;
    __device__ __forceinline__ void operator()(const Acc& acc, const Unit& u, int wr, int wc, int fr, int fq) const {
        float rsv[8]; f32x4 pv[8];
#pragma unroll
        for (int r8 = 0; r8 < 8; ++r8) { const int row = u.pm * BM + (r8 >> 2) * HALF + wr * 64 + (r8 & 3) * 16 + fr; pv[r8] = *(const f32x4*)(ssq + (size_t)row * 16 + fq * 4); }
        __builtin_amdgcn_sched_barrier(0);
#pragma unroll
        for (int r8 = 0; r8 < 8; ++r8) rsv[r8] = rsqrtf(xfq((pv[r8][0] + pv[r8][1]) + (pv[r8][2] + pv[r8][3])) * (1.0f / DM) + NEPS);
#pragma unroll
        for (int ai = 0; ai < 2; ++ai)
#pragma unroll
            for (int m = 0; m < 4; ++m) {
                const int row = u.pm * BM + ai * HALF + wr * 64 + m * 16 + fr;
                const float rs = rsv[ai * 4 + m];
                float hv[8];
#pragma unroll
                for (int n = 0; n < 2; ++n)
#pragma unroll
                    for (int j = 0; j < 4; ++j) { const float gv = acc[ai][0][m][n][j] * rs, uv = acc[ai][1][m][n][j] * rs; hv[4 * n + j] = gv * sigmoidf_(gv) * uv; }
                *(u32x4*)(H + (size_t)row * FF + u.pn * HALF + wc * 32 + fq * 8) = pk8(hv);
            }
    }
};
struct EpiRes {
    const float* xin; float* xout; bf16_t* xb; float* ssq_next; float alpha; int dry;
    __device__ __forceinline__ void operator()(const Acc& acc, const Unit& u, int wr, int wc, int fr, int fq) const {
#pragma unroll
        for (int ai = 0; ai < 2; ++ai)
#pragma unroll
            for (int m = 0; m < 4; ++m) {
                const int row = u.pm * BM + ai * HALF + wr * 64 + m * 16 + fr;
                float sq = 0.f;
#pragma unroll
                for (int bj = 0; bj < 2; ++bj) {
                    const size_t off = (size_t)row * DM + u.pn * BM + bj * HALF + wc * 32 + fq * 8;
                    f32x4 x0 = *(const f32x4*)(xin + off), x1 = *(const f32x4*)(xin + off + 4);
                    x0 += alpha * acc[ai][bj][m][0]; x1 += alpha * acc[ai][bj][m][1];
                    if (dry <= 0) { *(f32x4*)(xout + off) = x0; *(f32x4*)(xout + off + 4) = x1; }
                    float v[8] = {x0[0], x0[1], x0[2], x0[3], x1[0], x1[1], x1[2], x1[3]};
                    if (dry >= 0) *(u32x4*)(xb + off) = pk8(v);
#pragma unroll
                    for (int j = 0; j < 8; ++j) sq += v[j] * v[j];
                }
                sq += __shfl_xor(sq, 16); sq += __shfl_xor(sq, 32);
                if (fq == 0) ssq_next[(size_t)row * 16 + u.pn * 4 + wc] = sq;
            }
    }
};
struct EpiWin {
    const float* ssq; const int* pos; bf16_t* U; float* ssq_q; float* ssq_kv; bf16_t* KR; bf16_t* VTR;
    __device__ __forceinline__ void operator()(const Acc& acc, const Unit& u, int wr, int wc, int fr, int fq) const {
        float rsv[8]; int posv[8]; f32x4 pv[8];
#pragma unroll
        for (int r8 = 0; r8 < 8; ++r8) { const int row = u.pm * BM + (r8 >> 2) * HALF + wr * 64 + (r8 & 3) * 16 + fr; pv[r8] = *(const f32x4*)(ssq + (size_t)row * 16 + fq * 4); posv[r8] = pos[row]; }
        __builtin_amdgcn_sched_barrier(0);
#pragma unroll
        for (int r8 = 0; r8 < 8; ++r8) rsv[r8] = rsqrtf(xfq((pv[r8][0] + pv[r8][1]) + (pv[r8][2] + pv[r8][3])) * (1.0f / DM) + NEPS);
#pragma unroll
        for (int bj = 0; bj < 2; ++bj) {
            const int hf = 2 * u.pn + bj;
            int mode = 0;
            if (hf == 12 || hf == 13 || hf == 16 || hf == 17) mode = 1; else if (hf == 18 || hf == 19) mode = 2; else if (hf >= 20 && hf <= 22) mode = 3;
            else if (hf == 23) mode = 4; else if (hf == 24) mode = 5; else if (hf == 26) mode = 6; else if (hf == 27) mode = 7;
            float inv[4];
#pragma unroll
            for (int q = 0; q < 4; ++q) { const int n = q >> 1, pp = q & 1;
                inv[q] = (mode == 7) ? exp2f(-(float)(4 * fq + 2 * n + pp) * (13.287712379549449f / 16.0f)) : exp2f(-(float)(16 * (wc & 1) + 4 * fq + 2 * n + pp) * (13.287712379549449f / 32.0f)); }
#pragma unroll
            for (int ai = 0; ai < 2; ++ai)
#pragma unroll
                for (int m = 0; m < 4; ++m) {
                    const int row = u.pm * BM + ai * HALF + wr * 64 + m * 16 + fr;
                    const float rs = rsv[ai * 4 + m];
                    float v[8];
#pragma unroll
                    for (int n = 0; n < 2; ++n)
#pragma unroll
                        for (int j = 0; j < 4; ++j) v[4 * n + j] = acc[ai][bj][m][n][j] * rs;
                    if (mode == 1 || mode == 7) {
                        const int p = posv[ai * 4 + m];
#pragma unroll
                        for (int q = 0; q < 4; ++q) { float c, s; rope_cs(p, inv[q], c, s); const float x1 = v[2 * q], x2 = v[2 * q + 1]; v[2 * q] = x1 * c - x2 * s; v[2 * q + 1] = x1 * s + x2 * c; }
                    } else if (mode == 5) {
#pragma unroll
                        for (int j = 0; j < 8; ++j) { const float e = __expf(2.0f * v[j]); v[j] = 1.0f - 2.0f * __builtin_amdgcn_rcpf(e + 1.0f); }
                    } else if (mode == 6) {
#pragma unroll
                        for (int j = 0; j < 8; ++j) v[j] = sigmoidf_(v[j]);
                    }
                    if (mode == 2) {
                        const int b = row >> 11, t = row & 2047, h = 2 * (hf - 18) + (wc >> 1), dv0 = 32 * (wc & 1) + 8 * fq;
                        bf16_t* vt = VTR + ((size_t)((b * 4 + h) * 64 + dv0)) * SEQ + t;
#pragma unroll
                        for (int j = 0; j < 8; ++j) vt[(size_t)j * SEQ] = (bf16_t)f2bf(v[j]);
                    } else if (mode == 7) {
                        if (wc == 0) *(u32x4*)(KR + (size_t)row * 32 + fq * 8) = pk8(v);
                    } else {
                        *(u32x4*)(U + (size_t)row * NU + hf * HALF + wc * 32 + fq * 8) = pk8(v);
                        if (mode == 3 || mode == 4) {
                            float sq = 0.f;
#pragma unroll
                            for (int j = 0; j < 8; ++j) sq += v[j] * v[j];
                            sq += __shfl_xor(sq, 16); sq += __shfl_xor(sq, 32);
                            if (fq == 0) { if (mode == 3) ssq_q[(size_t)row * 16 + (hf - 20) * 4 + wc] = sq; else ssq_kv[(size_t)row * 4 + wc] = sq; }
                        }
                    }
                }
        }
    }
};
struct EpiLora {
    unsigned char* ws; const float* b0; const float* b1; const float* b2; const float* b3;
    __device__ __forceinline__ void operator()(const Acc& acc, const Unit& u, int wr, int wc, int fr, int fq) const {
        const int comp = u.pn;
        bf16_t* D = (bf16_t*)(ws + (comp < 3 ? WS_EF + (size_t)comp * 8 * MiB : WS_AB + (size_t)(comp - 3) * 8 * MiB));
        const float* B = comp == 0 ? b0 : comp == 1 ? b1 : comp == 2 ? b2 : b3;
        const float c0 = comp < 2 ? 0.6065306597126334f : 1.0f;
        const bool act = comp < 4;
#pragma unroll
        for (int bj = 0; bj < 2; ++bj) {
            const int ch = bj * HALF + wc * 32 + fq * 8;
            f32x4 bb0 = {0.f, 0.f, 0.f, 0.f}, bb1 = {0.f, 0.f, 0.f, 0.f};
            if (act) { bb0 = *(const f32x4*)(B + ch); bb1 = *(const f32x4*)(B + ch + 4); }
#pragma unroll
            for (int ai = 0; ai < 2; ++ai)
#pragma unroll
                for (int m = 0; m < 4; ++m) {
                    const int row = u.pm * BM + ai * HALF + wr * 64 + m * 16 + fr;
                    const f32x4 x0 = acc[ai][bj][m][0] + bb0, x1 = acc[ai][bj][m][1] + bb1;
                    float v[8] = {x0[0], x0[1], x0[2], x0[3], x1[0], x1[1], x1[2], x1[3]};
                    if (act) {
#pragma unroll
                        for (int j = 0; j < 8; ++j) v[j] = c0 * sigmoidf_(v[j]);
                    }
                    *(u32x4*)(D + (size_t)row * 256 + ch) = pk8(v);
                }
        }
    }
};
struct EpiMla {
    const float* ssq_q; const float* ssq_kv; const int* pos; bf16_t* QM; bf16_t* KN; bf16_t* VTM;
    __device__ __forceinline__ void operator()(const Acc& acc, const Unit& u, int wr, int wc, int fr, int fq) const {
        float inv[4];
#pragma unroll
        for (int q = 0; q < 4; ++q) inv[q] = exp2f(-(float)(4 * fq + q) * (13.287712379549449f / 16.0f));
        float rsq[8], rskv[8]; int posv[8];
        f32x4 pv[8];
#pragma unroll
        for (int r8 = 0; r8 < 8; ++r8) { const int row = u.pm * BM + (r8 >> 2) * HALF + wr * 64 + (r8 & 3) * 16 + fr; pv[r8] = *(const f32x4*)(ssq_q + (size_t)row * 16 + fq * 4); rskv[r8] = ssq_kv[(size_t)row * 4 + fq]; posv[r8] = pos[row]; }
        __builtin_amdgcn_sched_barrier(0);
#pragma unroll
        for (int r8 = 0; r8 < 8; ++r8) { const float q4 = fq < 3 ? (pv[r8][0] + pv[r8][1]) + (pv[r8][2] + pv[r8][3]) : 0.f; rsq[r8] = rsqrtf(xfq(q4) * (1.0f / 384.0f) + NEPS); rskv[r8] = rsqrtf(xfq(rskv[r8]) * (1.0f / 128.0f) + NEPS); }
#pragma unroll
        for (int bj = 0; bj < 2; ++bj) {
            const int n0 = u.pn * BM + bj * HALF + wc * 32;
            if (n0 >= 896) continue;
            const bool isq = n0 < 384;
            const bool isrope = isq && ((n0 >> 5) % 3 == 2);
            const int nn = n0 - 384, hh = nn >> 7, c0 = nn & 127;
#pragma unroll
            for (int ai = 0; ai < 2; ++ai)
#pragma unroll
                for (int m = 0; m < 4; ++m) {
                    const int row = u.pm * BM + ai * HALF + wr * 64 + m * 16 + fr;
                    const float rs = isq ? rsq[ai * 4 + m] : rskv[ai * 4 + m];
                    float v[8];
#pragma unroll
                    for (int n = 0; n < 2; ++n)
#pragma unroll
                        for (int j = 0; j < 4; ++j) v[4 * n + j] = acc[ai][bj][m][n][j] * rs;
                    if (isq) {
                        if (isrope) { const int p = posv[ai * 4 + m];
#pragma unroll
                            for (int q = 0; q < 4; ++q) { float c, s; rope_cs(p, inv[q], c, s); const float x1 = v[2 * q], x2 = v[2 * q + 1]; v[2 * q] = x1 * c - x2 * s; v[2 * q + 1] = x1 * s + x2 * c; } }
                        *(u32x4*)(QM + (size_t)row * 384 + n0 + fq * 8) = pk8(v);
                    } else if (c0 < 64) {
                        *(u32x4*)(KN + (size_t)row * 256 + hh * 64 + c0 + fq * 8) = pk8(v);
                    } else {
                        const int b = row >> 11, t = row & 2047, dv0 = c0 - 64 + 8 * fq;
                        bf16_t* vt = VTM + ((size_t)((b * 4 + hh) * 64 + dv0)) * SEQ + t;
#pragma unroll
                        for (int j = 0; j < 8; ++j) vt[(size_t)j * SEQ] = (bf16_t)f2bf(v[j]);
                    }
                }
        }
    }
};
}

template <int MODE>
__device__ __forceinline__ void attn_unit(LAS unsigned char* lds, unsigned char* ws, const float* gn_g, int unit, const int tid, const int ocol = U_TG) {
    constexpr int DQK = MODE == 0 ? 96 : 64, NS = DQK / 16, KS = (DQK + 8) * 2, VS = 136, KBUF = 64 * KS, VBUF = 64 * VS, CPR = DQK / 8, NKC = 64 * CPR;
    const int wid = tid >> 6, lane = tid & 63, ql = lane & 31, hi = lane >> 5;
    const int b = unit >> 5, h = (unit >> 3) & 3, qb = unit & 7;
    const int tok0 = b * SEQ, qi = qb * 256 + wid * 32 + ql;
    bf16_t* U = (bf16_t*)(ws + WS_U);
    const bf16_t* QM = (const bf16_t*)(ws + WS_QM); const bf16_t* KN = (const bf16_t*)(ws + WS_KN); const bf16_t* KR = (const bf16_t*)(ws + WS_KR);
    const bf16_t* VT = (const bf16_t*)(ws + (MODE == 0 ? WS_VTM : WS_VTR)) + (size_t)((b * 4 + h) * 64) * SEQ;
    bf16x8 qf[NS];
    { const bf16_t* qrow = MODE == 0 ? QM + (size_t)(tok0 + qi) * 384 + h * 96 : U + (size_t)(tok0 + qi) * NU + U_TQ + h * 64;
#pragma unroll
      for (int s = 0; s < NS; ++s) qf[s] = *(const bf16x8*)(qrow + 16 * s + 8 * hi); }
    const int kc0 = tid, kc1 = tid + 512;
    const int vdv = tid >> 3, vcc = tid & 7;
    u32x4 kreg0, kreg1 = {0, 0, 0, 0}, vreg;
    auto kaddr = [&](int c, int j0) -> const bf16_t* {
        const int key = c / CPR, cc = c % CPR; const size_t tok = (size_t)(tok0 + j0 + key);
        if (MODE == 0) return cc < 8 ? KN + tok * 256 + h * 64 + cc * 8 : KR + tok * 32 + (cc - 8) * 8;
        return U + tok * NU + U_TK + h * 64 + cc * 8;
    };
    auto gload = [&](int j0) {
        kreg0 = *(const u32x4*)kaddr(kc0, j0);
        if (kc1 < NKC) kreg1 = *(const u32x4*)kaddr(kc1, j0);
        vreg = *(const u32x4*)(VT + (size_t)vdv * SEQ + j0 + vcc * 8);
    };
    auto lwrite = [&](int buf) {
        LAS unsigned char* kb = lds + buf * KBUF; LAS unsigned char* vb = lds + 2 * KBUF + buf * VBUF;
        *(LAS u32x4*)(kb + (kc0 / CPR) * KS + (kc0 % CPR) * 16) = kreg0;
        if (kc1 < NKC) *(LAS u32x4*)(kb + (kc1 / CPR) * KS + (kc1 % CPR) * 16) = kreg1;
        *(LAS u32x2*)(vb + vdv * VS + vcc * 16) = (u32x2){vreg.x, vreg.y};
        *(LAS u32x2*)(vb + vdv * VS + vcc * 16 + 8) = (u32x2){vreg.z, vreg.w};
    };
    f32x16 ot[2];
#pragma unroll
    for (int i = 0; i < 16; ++i) { ot[0][i] = 0.f; ot[1][i] = 0.f; }
    float mrun = -1e30f, lrun = 0.f;
    const float lgam = MODE == 1 ? log2f(1.0f - exp2f(-5.0f - (float)h)) : 0.f;
    __syncthreads();
    gload(0); lwrite(0);
    __syncthreads();
    constexpr int NT = SEQ / 64;
    for (int t = 0; t < NT; ++t) {
        const int buf = t & 1;
        if (t + 1 < NT) gload((t + 1) * 64);
        LAS unsigned char* kb = lds + buf * KBUF; LAS unsigned char* vb = lds + 2 * KBUF + buf * VBUF;
        f32x16 st[2];
#pragma unroll
        for (int i = 0; i < 16; ++i) { st[0][i] = 0.f; st[1][i] = 0.f; }
        {
            bf16x8 kfr[2][NS];
#pragma unroll
            for (int kt2 = 0; kt2 < 2; ++kt2)
#pragma unroll
                for (int s = 0; s < NS; ++s) kfr[kt2][s] = *(const LAS bf16x8*)(kb + (32 * kt2 + ql) * KS + (16 * s + 8 * hi) * 2);
            __builtin_amdgcn_sched_barrier(0);
#pragma unroll
            for (int s = 0; s < NS; ++s)
#pragma unroll
                for (int kt2 = 0; kt2 < 2; ++kt2) st[kt2] = __builtin_amdgcn_mfma_f32_32x32x16_bf16(kfr[kt2][s], qf[s], st[kt2], 0, 0, 0);
        }
        u32x4 vfr[2][2][2];
#pragma unroll
        for (int kt2 = 0; kt2 < 2; ++kt2)
#pragma unroll
            for (int s2 = 0; s2 < 2; ++s2)
#pragma unroll
                for (int dt = 0; dt < 2; ++dt) {
                    LAS unsigned char* vp = vb + (32 * dt + ql) * VS + (32 * kt2 + 16 * s2 + 4 * hi) * 2;
                    const u32x2 v0 = *(const LAS u32x2*)vp, v1 = *(const LAS u32x2*)(vp + 16);
                    vfr[kt2][s2][dt] = (u32x4){v0.x, v0.y, v1.x, v1.y};
                }
        __builtin_amdgcn_sched_barrier(0);
        if (MODE == 0) {
            float mx = st[0][0];
#pragma unroll
            for (int i = 0; i < 16; ++i) { mx = fmaxf(mx, st[0][i]); mx = fmaxf(mx, st[1][i]); }
            mx = fmaxf(mx, __shfl_xor(mx, 32));
            const float mnew = fmaxf(mrun, mx), alpha = __builtin_amdgcn_exp2f(mrun - mnew);
            mrun = mnew; float ls = 0.f;
#pragma unroll
            for (int i = 0; i < 16; ++i) { st[0][i] = __builtin_amdgcn_exp2f(st[0][i] - mnew); st[1][i] = __builtin_amdgcn_exp2f(st[1][i] - mnew); ls += st[0][i] + st[1][i]; }
            lrun = lrun * alpha + ls;
            if (__builtin_amdgcn_ballot_w64(alpha != 1.0f)) {
#pragma unroll
                for (int i = 0; i < 16; ++i) { ot[0][i] *= alpha; ot[1][i] *= alpha; }
            }
        } else {
            const float dq = (float)(qi - (t * 64 + 4 * hi));
#pragma unroll
            for (int kt2 = 0; kt2 < 2; ++kt2)
#pragma unroll
                for (int i = 0; i < 16; ++i) { const float d = fabsf(dq - (float)(32 * kt2 + 8 * (i >> 2) + (i & 3))); st[kt2][i] *= __builtin_amdgcn_exp2f(lgam * d); }
        }
        {
#pragma unroll
            for (int kt2 = 0; kt2 < 2; ++kt2)
#pragma unroll
                for (int s2 = 0; s2 < 2; ++s2) {
                    u32x4 pw; pw.x = pk2(st[kt2][8 * s2 + 0], st[kt2][8 * s2 + 1]); pw.y = pk2(st[kt2][8 * s2 + 2], st[kt2][8 * s2 + 3]);
                    pw.z = pk2(st[kt2][8 * s2 + 4], st[kt2][8 * s2 + 5]); pw.w = pk2(st[kt2][8 * s2 + 6], st[kt2][8 * s2 + 7]);
                    const bf16x8 pf = __builtin_bit_cast(bf16x8, pw);
#pragma unroll
                    for (int dt = 0; dt < 2; ++dt) ot[dt] = __builtin_amdgcn_mfma_f32_32x32x16_bf16(__builtin_bit_cast(bf16x8, vfr[kt2][s2][dt]), pf, ot[dt], 0, 0, 0);
                }
        }
        if (t + 1 < NT) lwrite(buf ^ 1);
        __syncthreads();
    }
    const size_t orow = (size_t)(tok0 + qi) * NU;
    if (MODE == 0) {
        const float ltot = lrun + __shfl_xor(lrun, 32), il = 1.0f / ltot;
#pragma unroll
        for (int dt = 0; dt < 2; ++dt)
#pragma unroll
            for (int g = 0; g < 4; ++g) {
                u32x2 w; w.x = pk2(ot[dt][4 * g] * il, ot[dt][4 * g + 1] * il); w.y = pk2(ot[dt][4 * g + 2] * il, ot[dt][4 * g + 3] * il);
                *(u32x2*)(U + orow + U_QA + h * 64 + 32 * dt + 8 * g + 4 * hi) = w;
            }
    } else {
        float sq = 0.f;
#pragma unroll
        for (int i = 0; i < 16; ++i) sq += ot[0][i] * ot[0][i] + ot[1][i] * ot[1][i];
        sq += __shfl_xor(sq, 32);
        const float rs = rsqrtf(sq * (1.0f / 64.0f) + NEPS);
#pragma unroll
        for (int dt = 0; dt < 2; ++dt)
#pragma unroll
            for (int g = 0; g < 4; ++g) {
                const int dv = 32 * dt + 8 * g + 4 * hi;
                bf16_t* gp = U + orow + U_TG + h * 64 + dv;
                const u32x2 gw = *(const u32x2*)gp;
                const float g0 = bflo(gw.x), g1 = bfhi(gw.x), g2 = bflo(gw.y), g3 = bfhi(gw.y);
                const f32x4 gg = *(const f32x4*)(gn_g + h * 64 + dv);
                const float o0 = ot[dt][4 * g] * rs * gg[0] * g0 * sigmoidf_(g0), o1 = ot[dt][4 * g + 1] * rs * gg[1] * g1 * sigmoidf_(g1);
                const float o2 = ot[dt][4 * g + 2] * rs * gg[2] * g2 * sigmoidf_(g2), o3 = ot[dt][4 * g + 3] * rs * gg[3] * g3 * sigmoidf_(g3);
                u32x2 w; w.x = pk2(o0, o1); w.y = pk2(o2, o3);
                *(u32x2*)(U + orow + ocol + h * 64 + dv) = w;
            }
    }
}

struct ScOp { f32x4 w4, kk, nb, kd, r4; float v1; };
#define SC_LD(x, s) do { asm volatile("ds_read_b128 %0, %1 offset:%2" : "=v"(x.w4) : "v"(ao), "n"((s) * 1280)); asm volatile("ds_read_b128 %0, %1 offset:%2" : "=v"(x.kk) : "v"(ao), "n"((s) * 1280 + 256)); \
        asm volatile("ds_read_b128 %0, %1 offset:%2" : "=v"(x.nb) : "v"(ao), "n"((s) * 1280 + 512)); asm volatile("ds_read_b128 %0, %1 offset:%2" : "=v"(x.kd) : "v"(ao), "n"((s) * 1280 + 768)); \
        asm volatile("ds_read_b128 %0, %1 offset:%2" : "=v"(x.r4) : "v"(ao), "n"((s) * 1280 + 1024)); asm volatile("ds_read_b32 %0, %1 offset:%2" : "=v"(x.v1) : "v"(av), "n"((s) * 128)); } while (0)
#define SC_WAIT(x, n) asm volatile("s_waitcnt lgkmcnt(" #n ")" : "+v"(x.w4), "+v"(x.kk), "+v"(x.nb), "+v"(x.kd), "+v"(x.r4), "+v"(x.v1) :: "memory")
#define SC_UPD(x) do { p[0] = __builtin_fmaf(sa, x.nb[0], __builtin_fmaf(p[0], x.w4[0], x.v1 * x.kd[0])); p[1] = __builtin_fmaf(sa, x.nb[1], __builtin_fmaf(p[1], x.w4[1], x.v1 * x.kd[1])); \
        p[2] = __builtin_fmaf(sa, x.nb[2], __builtin_fmaf(p[2], x.w4[2], x.v1 * x.kd[2])); p[3] = __builtin_fmaf(sa, x.nb[3], __builtin_fmaf(p[3], x.w4[3], x.v1 * x.kd[3])); \
        ycar = __builtin_fmaf(p[3], x.r4[3], __builtin_fmaf(p[2], x.r4[2], __builtin_fmaf(p[1], x.r4[1], p[0] * x.r4[0]))); } while (0)
#define SC_MATH0(x) do { float sa = __builtin_fmaf(p[3], x.kk[3], __builtin_fmaf(p[2], x.kk[2], __builtin_fmaf(p[1], x.kk[1], p[0] * x.kk[0]))); sa = rowsum16(sa); SC_UPD(x); } while (0)
#define SC_MATH(x, s) do { float sa = __builtin_fmaf(p[3], x.kk[3], __builtin_fmaf(p[2], x.kk[2], __builtin_fmaf(p[1], x.kk[1], p[0] * x.kk[0]))); \
        sa += dppf<0xB1>(sa); ycar += dppf<0xB1>(ycar); sa += dppf<0x4E>(sa); ycar += dppf<0x4E>(ycar); sa += dppf<0x124>(sa); ycar += dppf<0x124>(ycar); sa += dppf<0x128>(sa); ycar += dppf<0x128>(ycar); \
        *(LAS float*)(yo + ((s) - 1) * 128) = ycar; SC_UPD(x); } while (0)
#define SC_STEP(cur, nxt, s, n) do { SC_LD(nxt, (s) + 1); SC_WAIT(cur, n); SC_MATH(cur, s); } while (0)
#define SC_STEP4(s) do { SC_STEP(ca, cb, s, 7); SC_STEP(cb, ca, (s) + 1, 7); SC_STEP(ca, cb, (s) + 2, 7); SC_STEP(cb, ca, (s) + 3, 7); } while (0)
__device__ __forceinline__ void rwkv_scan(LAS unsigned char* lds, unsigned char* ws, const float* k_k, const float* k_a, int sidx, const int tid) {
    constexpr int TC = 32, OPB = TC * 5 * 64 * 4, VVB = TC * 32 * 4, YOB = TC * 32 * 4;
    const int wid = tid >> 6, lane = tid & 63;
    const int scan = sidx >> 1, hb = sidx & 1, b = scan >> 3, h = (scan >> 1) & 3, dir = scan & 1;
    const bf16_t* U = (const bf16_t*)(ws + WS_U);
    const bf16_t* E = (const bf16_t*)(ws + (dir ? WS_EB : WS_EF)); const bf16_t* A = (const bf16_t*)(ws + (dir ? WS_AB : WS_AF));
    bf16_t* Y = (bf16_t*)(ws + (dir ? WS_YB : WS_YF));
    LAS unsigned char* ops = lds; LAS unsigned char* vvb = lds + 2 * OPB; LAS unsigned char* yob = lds + 2 * OPB + 2 * VVB;
    const int ts = tid >> 4, cj = tid & 15, ch = h * 64 + 4 * cj;
    const f32x4 kk_w = *(const f32x4*)(k_k + ch), ka_w = *(const f32x4*)(k_a + ch);
    struct G { u32x2 rk, rr, rv, re, ra; };
    auto gload = [&](int c) -> G {
        G g;
        const int sI = c * TC + ts, t = dir ? (SEQ - 1 - sI) : sI; const size_t row = (size_t)(b * SEQ + t);
        g.rk = *(const u32x2*)(U + row * NU + U_RK + ch); g.rr = *(const u32x2*)(U + row * NU + U_RR + ch); g.rv = *(const u32x2*)(U + row * NU + U_RV + ch);
        g.re = *(const u32x2*)(E + row * 256 + ch); g.ra = *(const u32x2*)(A + row * 256 + ch);
        return g;
    };
    auto lwrite = [&](int buf, const G& g) {
        const u32x2 rk = g.rk, rr = g.rr, rv = g.rv, re = g.re, ra = g.ra;
        const f32x4 k4 = {bflo(rk.x), bfhi(rk.x), bflo(rk.y), bfhi(rk.y)}, r4 = {bflo(rr.x), bfhi(rr.x), bflo(rr.y), bfhi(rr.y)}, v4 = {bflo(rv.x), bfhi(rv.x), bflo(rv.y), bfhi(rv.y)};
        const f32x4 e4 = {bflo(re.x), bfhi(re.x), bflo(re.y), bfhi(re.y)}, a4 = {bflo(ra.x), bfhi(ra.x), bflo(ra.y), bfhi(ra.y)};
        f32x4 kk = k4 * kk_w;
        float ss = kk[0] * kk[0] + kk[1] * kk[1] + kk[2] * kk[2] + kk[3] * kk[3];
        ss = rowsum16(ss);
        const float nrm = __builtin_amdgcn_rcpf(fmaxf(__builtin_amdgcn_sqrtf(ss), 1e-12f));
        kk = kk * nrm;
        const f32x4 nb = -(kk * a4);
        f32x4 w4; w4[0] = __expf(-e4[0]); w4[1] = __expf(-e4[1]); w4[2] = __expf(-e4[2]); w4[3] = __expf(-e4[3]);
        const f32x4 kd = k4 * (1.0f + (a4 - 1.0f) * ka_w);
        LAS unsigned char* o = ops + buf * OPB + ts * 1280 + cj * 16;
        *(LAS f32x4*)(o) = w4; *(LAS f32x4*)(o + 256) = kk; *(LAS f32x4*)(o + 512) = nb; *(LAS f32x4*)(o + 768) = kd; *(LAS f32x4*)(o + 1024) = r4;
        if ((cj >> 3) == hb) *(LAS f32x4*)(vvb + buf * VVB + ts * 128 + (cj & 7) * 16) = v4;
    };
    auto flush = [&](int c) {
#pragma unroll
        for (int i = 0; i < 2; ++i) {
            const int idx = tid + i * 512, s = idx >> 5, ri = idx & 31;
            const int sI = c * TC + s, t = dir ? (SEQ - 1 - sI) : sI;
            const float yv = *(const LAS float*)(yob + (c & 1) * YOB + s * 128 + ri * 4);
            Y[(size_t)(b * SEQ + t) * 256 + h * 64 + 32 * hb + ri] = (bf16_t)f2bf(yv);
        }
    };
    f32x4 p = {0.f, 0.f, 0.f, 0.f};
    const int rr4 = lane >> 4, lc = lane & 15, rowA = 4 * wid + rr4;
    auto compute = [&](int buf) {
        const unsigned ao = (unsigned)(unsigned long long)(ops + buf * OPB + lc * 16), av = (unsigned)(unsigned long long)(vvb + buf * VVB + rowA * 4);
        LAS unsigned char* yo = yob + buf * YOB + rowA * 4;
        ScOp ca, cb;
        SC_LD(ca, 0);
        float ycar = 0.f;
        SC_LD(cb, 1); SC_WAIT(ca, 6); SC_MATH0(ca); SC_STEP(cb, ca, 1, 6); SC_STEP(ca, cb, 2, 7); SC_STEP(cb, ca, 3, 7);
        SC_STEP4(4); SC_STEP4(8); SC_STEP4(12); SC_STEP4(16); SC_STEP4(20); SC_STEP4(24);
        SC_STEP(ca, cb, 28, 7); SC_STEP(cb, ca, 29, 7); SC_STEP(ca, cb, 30, 7);
        SC_WAIT(cb, 1); SC_MATH(cb, 31);
        ycar = rowsum16(ycar); *(LAS float*)(yo + 31 * 128) = ycar;
    };
    constexpr int NC = SEQ / TC;
    G g0, g1;
    __syncthreads();
    { const G t0 = gload(0); lwrite(0, t0); g0 = gload(1); g1 = gload(2); }
    __syncthreads();
    for (int c = 0; c < NC; c += 2) {
        compute(0); lwrite(1, g0); if (c + 3 < NC) g0 = gload(c + 3);
        __syncthreads();
        flush(c);
        compute(1); if (c + 2 < NC) { lwrite(0, g1); if (c + 4 < NC) g1 = gload(c + 4); }
        __syncthreads();
        flush(c + 1);
    }
    __syncthreads();
}

__device__ __forceinline__ const void* ldptr(volatile LAS unsigned long long* t, int i);
template <class F> __device__ __forceinline__ void conv_mat(bf16_t* dst, int N, int K, F f, long gtid, long gthreads) {
    const unsigned nlines = (unsigned)N * (unsigned)(K >> 6);
    const unsigned li0 = (unsigned)(gtid >> 3), dli = (unsigned)(gthreads >> 3), sub = (unsigned)gtid & 7u;
    unsigned n = li0 % (unsigned)N, kl = li0 / (unsigned)N;
    const unsigned dn = dli % (unsigned)N, dk = dli / (unsigned)N;
    for (unsigned li = li0; li < nlines; li += 4u * dli) {
        unsigned nn[4], kk[4]; bool ok[4];
#pragma unroll
        for (int q = 0; q < 4; ++q) { ok[q] = li + (unsigned)q * dli < nlines; nn[q] = ok[q] ? n : nn[0]; kk[q] = ok[q] ? kl : kk[0]; n += dn; kl += dk; if (n >= (unsigned)N) { n -= (unsigned)N; ++kl; } }
        float w[4][8], m[4][8], sc[4];
#pragma unroll
        for (int q = 0; q < 4; ++q) f((int)nn[q], (int)(sub + 8u * kk[q]) * 8, w[q], m[q], sc[q]);
        __builtin_amdgcn_sched_barrier(0);
#pragma unroll
        for (int q = 0; q < 4; ++q) {
            float v[8];
#pragma unroll
            for (int i = 0; i < 8; ++i) v[i] = w[q][i] * m[q][i] * sc[q];
            if (ok[q]) *(u32x4*)(dst + (size_t)nn[q] * K + (sub + 8u * kk[q]) * 8) = pk8(v);
        }
    }
}
typedef const __attribute__((address_space(1))) float* gfp_t;
#define GLD(p, i) (((gfp_t)(p))[(i)])
__device__ __forceinline__ void convert_region_a(volatile LAS unsigned long long* ptab, int l, long gtid, long gth) {
    unsigned char* ws = (unsigned char*)ldptr(ptab, 35);
    {
        const float* wg = ((const float*)ldptr(ptab, 3)) + (size_t)l * DM * FF; const float* wu = ((const float*)ldptr(ptab, 4)) + (size_t)l * DM * FF; const float* nr = ((const float*)ldptr(ptab, 2)) + l * DM;
        conv_mat((bf16_t*)(ws + WS_WGU1), 2 * FF, DM, [=](int n, int k0, float* w, float* m, float& sc) { const int pn = n >> 8, rr = n & 255; const float* src = (rr >> 7) ? wu : wg; const int j = pn * 128 + (rr & 127);
#pragma unroll
            for (int i = 0; i < 8; ++i) { w[i] = GLD(src, (size_t)(k0 + i) * FF + j); m[i] = GLD(nr, k0 + i); } sc = 1.f; }, gtid, gth);
    }
    {   const float* wd = ((const float*)ldptr(ptab, 5)) + (size_t)l * FF * DM;
        conv_mat((bf16_t*)(ws + WS_WD1), DM, FF, [=](int n, int k0, float* w, float* m, float& sc) {
#pragma unroll
            for (int i = 0; i < 8; ++i) { w[i] = GLD(wd, (size_t)(k0 + i) * DM + n); m[i] = 1.f; } sc = 1.f; }, gtid, gth);
    }
    {
        const float* wi = ((const float*)ldptr(ptab, 7)) + (size_t)l * DM * INW; const float* nr = ((const float*)ldptr(ptab, 6)) + l * DM;
        conv_mat((bf16_t*)(ws + WS_WIN), NU, DM, [=](int n, int k0, float* w, float* m, float& sc) {
            int s; float scl = 1.f;
            if (n < 768) s = n;
            else if (n < 1024) s = 1024 + (n - 768);
            else if (n < 1280) s = 768 + (n - 1024);
            else if (n < 1536) s = n;
            else if (n < 1792) { const int j = n - 1536, c = j & 63; s = 1920 + (j & ~63) + (c >> 1) + 32 * (c & 1); }
            else if (n < 2048) s = 2688 + (n - 1792);
            else if (n < 2304) { const int j = n - 2048, c = j & 63; s = 2176 + (j & ~63) + (c >> 1) + 32 * (c & 1); scl = 0.125f; }
            else if (n < 2560) s = 2432 + (n - 2304);
            else if (n < 2944) s = 2944 + (n - 2560);
            else if (n < 3072) s = 3328 + (n - 2944);
            else if (n < 3456) s = 1536 + (n - 3072);
            else if (n < 3488) { const int c = n - 3456; s = 3456 + (c >> 1) + 16 * (c & 1); }
            else { s = 0; scl = 0.f; }
#pragma unroll
            for (int i = 0; i < 8; ++i) { w[i] = GLD(wi, (size_t)(k0 + i) * INW + s); m[i] = GLD(nr, k0 + i); } sc = scl; }, gtid, gth);
    }
    {
        const float* w2f = ((const float*)ldptr(ptab, 12)) + l * 64 * 256; const float* w2b = ((const float*)ldptr(ptab, 13)) + l * 64 * 256; const float* a2f = ((const float*)ldptr(ptab, 16)) + l * 64 * 256; const float* a2b = ((const float*)ldptr(ptab, 17)) + l * 64 * 256; const float* g2 = ((const float*)ldptr(ptab, 18)) + l * 128 * 256;
        conv_mat((bf16_t*)(ws + WS_WLORA), 1280, 384, [=](int n, int k0, float* w, float* m, float& sc) {
            const int comp = n >> 8, c = n & 255; const float* src = w2f; int kr = 0; float mm = 0.f;
            if (comp == 0 && k0 < 64) { src = w2f; kr = k0; mm = 1.f; } else if (comp == 1 && k0 >= 64 && k0 < 128) { src = w2b; kr = k0 - 64; mm = 1.f; }
            else if (comp == 2 && k0 >= 128 && k0 < 192) { src = a2f; kr = k0 - 128; mm = 1.f; } else if (comp == 3 && k0 >= 192 && k0 < 256) { src = a2b; kr = k0 - 192; mm = 1.f; }
            else if (comp == 4 && k0 >= 256) { src = g2; kr = k0 - 256; mm = 1.f; }
#pragma unroll
            for (int i = 0; i < 8; ++i) { w[i] = GLD(src, (size_t)(kr + i) * 256 + c); m[i] = 1.f; } sc = mm; }, gtid, gth);
    }
    {
        const float* qb = ((const float*)ldptr(ptab, 26)) + (size_t)l * 384 * 384; const float* qn = ((const float*)ldptr(ptab, 25)) + l * 384; const float* kvb = ((const float*)ldptr(ptab, 28)) + (size_t)l * 128 * 512; const float* kvn = ((const float*)ldptr(ptab, 27)) + l * 128;
        const float qscale = 0.10206207261596577f * 1.4426950408889634f;
        conv_mat((bf16_t*)(ws + WS_WMLA), 1024, 512, [=](int n, int k0, float* w, float* m, float& sc) {
            const float* wp = qb; const float* np = qn; int stride = 384, col = 0, kr = 0; float mm = 0.f;
            if (n < 384 && k0 < 384) { const int hh = n / 96, c = n % 96; int scol = c; if (c >= 64) { const int cc = c - 64; scol = 64 + (cc >> 1) + 16 * (cc & 1); }
                col = hh * 96 + scol; kr = k0; mm = qscale; }
            else if (n >= 384 && n < 896 && k0 >= 384) { wp = kvb; np = kvn; stride = 512; col = n - 384; kr = k0 - 384; mm = 1.f; }
#pragma unroll
            for (int i = 0; i < 8; ++i) { w[i] = GLD(wp, (size_t)(kr + i) * stride + col); m[i] = GLD(np, kr + i); } sc = mm; }, gtid, gth);
    }
}
__device__ __forceinline__ void convert_region_b(volatile LAS unsigned long long* ptab, int l, long gtid, long gth) {
    unsigned char* ws = (unsigned char*)ldptr(ptab, 35);
    {   const float* wo = ((const float*)ldptr(ptab, 8)) + (size_t)l * DM * DM;
        conv_mat((bf16_t*)(ws + WS_WOUT), DM, DM, [=](int n, int k0, float* w, float* m, float& sc) {
#pragma unroll
            for (int i = 0; i < 8; ++i) { w[i] = GLD(wo, (size_t)(k0 + i) * DM + n); m[i] = 1.f; } sc = 1.f; }, gtid, gth);
    }
    {   const float* wg = ((const float*)ldptr(ptab, 30)) + (size_t)l * DM * FF; const float* wu = ((const float*)ldptr(ptab, 31)) + (size_t)l * DM * FF; const float* nr = ((const float*)ldptr(ptab, 29)) + l * DM;
        conv_mat((bf16_t*)(ws + WS_WGU2), 2 * FF, DM, [=](int n, int k0, float* w, float* m, float& sc) { const int pn = n >> 8, rr = n & 255; const float* src = (rr >> 7) ? wu : wg; const int j = pn * 128 + (rr & 127);
#pragma unroll
            for (int i = 0; i < 8; ++i) { w[i] = GLD(src, (size_t)(k0 + i) * FF + j); m[i] = GLD(nr, k0 + i); } sc = 1.f; }, gtid, gth);
    }
    {   const float* wd = ((const float*)ldptr(ptab, 32)) + (size_t)l * FF * DM;
        conv_mat((bf16_t*)(ws + WS_WD2), DM, FF, [=](int n, int k0, float* w, float* m, float& sc) {
#pragma unroll
            for (int i = 0; i < 8; ++i) { w[i] = GLD(wd, (size_t)(k0 + i) * DM + n); m[i] = 1.f; } sc = 1.f; }, gtid, gth);
    }
}


#define XB_TMO      128
#define XB_XCNT(j)  (256  + 64 * (j))
#define XB_XSUB(j)  (1280 + 64 * (j))
#define XB_XGEN(j)  (2304 + 64 * (j))
#define XB_TOP      3328
#define XB_TOPGEN   3392
#define XCD_BAR_WORDS 3456
#define XB_SPIN_CAP (1u << 22)
__device__ __forceinline__ unsigned xb_ld(unsigned* p)              { return __hip_atomic_load(p, __ATOMIC_RELAXED, __HIP_MEMORY_SCOPE_AGENT); }
__device__ __forceinline__ unsigned xb_add(unsigned* p, unsigned v) { return __hip_atomic_fetch_add(p, v, __ATOMIC_RELAXED, __HIP_MEMORY_SCOPE_AGENT); }
__device__ __forceinline__ unsigned xb_xcc_id() { return (unsigned)__builtin_amdgcn_s_getreg((3 << 11) | 20) & 0xFu; }
#define XB_SPIN(cond, bar) do { unsigned _sp = 0; while (cond) { __builtin_amdgcn_s_sleep(1); \
    if ((++_sp & 255u) == 0u) { if (xb_ld(&(bar)[XB_TMO])) break; if (_sp > XB_SPIN_CAP) { atomicAdd(&(bar)[XB_TMO], 1u); break; } } } } while (0)
struct XcdBarrier { unsigned* bar; unsigned x; volatile LAS unsigned* st; };
__device__ __forceinline__ XcdBarrier xcd_barrier_post(unsigned* bar, volatile LAS unsigned* st) {
    XcdBarrier b; b.bar = bar; b.x = xb_xcc_id(); b.st = st;
    if (threadIdx.x == 0) (void)xb_add(&bar[XB_XCNT(b.x)], 1u);
    return b;
}
__device__ __forceinline__ void xcd_barrier_complete(unsigned* bar, unsigned x, unsigned& nloc, unsigned& nx) {
    const unsigned G = gridDim.x * gridDim.y * gridDim.z;
    unsigned sum, cnt, mine, sp = 0u;
    for (;;) {
        sum = 0u; cnt = 0u; mine = 0u;
#pragma unroll
        for (unsigned j = 0; j < 16; ++j) { const unsigned c = xb_ld(&bar[XB_XCNT(j)]); sum += c; cnt += (c > 0u) ? 1u : 0u; mine = (j == x) ? c : mine; }
        if (sum == G) break;
        __builtin_amdgcn_s_sleep(1);
        if ((++sp & 255u) == 0u) { if (xb_ld(&bar[XB_TMO])) break; if (sp > XB_SPIN_CAP) { atomicAdd(&bar[XB_TMO], 1u); break; } }
    }
    nloc = mine > 0u ? mine : 1u; nx = cnt > 0u ? cnt : 1u;
}
__device__ __forceinline__ void xcd_barrier(const XcdBarrier& b) {
    asm volatile("s_waitcnt vmcnt(0)" ::: "memory");
    __syncthreads();
    if (threadIdx.x == 0) {
        unsigned* bar = b.bar;
        __builtin_amdgcn_s_waitcnt(0);
        unsigned nloc = b.st[0], nx = b.st[1];
        if (nloc == 0u) { xcd_barrier_complete(bar, b.x, nloc, nx); b.st[0] = nloc; b.st[1] = nx; }
        const unsigned old = xb_add(&bar[XB_XSUB(b.x)], 1u);
        const unsigned gen = old / nloc;
        if (old + 1u == (gen + 1u) * nloc) {
            __builtin_amdgcn_fence(__ATOMIC_RELEASE, "agent");
            asm volatile("s_waitcnt vmcnt(0)" ::: "memory");
            const unsigned og = xb_add(&bar[XB_TOP], 1u);
            const unsigned tg = og / nx;
            if (og + 1u == (tg + 1u) * nx) xb_add(&bar[XB_TOPGEN], 1u);
            else XB_SPIN(xb_ld(&bar[XB_TOPGEN]) == tg, bar);
            __builtin_amdgcn_fence(__ATOMIC_ACQUIRE, "agent");
            xb_add(&bar[XB_XGEN(b.x)], 1u);
            asm volatile("s_waitcnt vmcnt(0)" ::: "memory");
        } else {
            XB_SPIN(xb_ld(&bar[XB_XGEN(b.x)]) == gen, bar);
            __builtin_amdgcn_fence(__ATOMIC_ACQUIRE, "agent");
            asm volatile("s_waitcnt vmcnt(0)" ::: "memory");
        }
    }
    __syncthreads();
}

constexpr int PTAB_OFF = 143360;
__device__ __forceinline__ const void* ldptr(volatile LAS unsigned long long* t, int i) {
    const unsigned long long v = t[i];
    const unsigned lo = __builtin_amdgcn_readfirstlane((unsigned)v), hi = __builtin_amdgcn_readfirstlane((unsigned)(v >> 32));
    return (const void*)(const __attribute__((address_space(1))) void*)(((unsigned long long)hi << 32) | lo);
}
#ifndef PHMASK
#define PHMASK 0xFFFF
#endif
#define PHON(i) ((PHMASK >> (i)) & 1)
#ifndef REPMASK
#define REPMASK 0
#endif
#define NREP(i) (((REPMASK >> (i)) & 1) ? 2 : 1)
__global__ void __launch_bounds__(512, 2) fwd_kernel(Args a) {
    extern __shared__ __attribute__((aligned(16))) unsigned char smem_raw[];
    LAS unsigned char* lds = (LAS unsigned char*)smem_raw;
    cg::grid_group grid = cg::this_grid();
    const int nb = gridDim.x, bid = blockIdx.x;
    volatile LAS unsigned long long* ptab = (volatile LAS unsigned long long*)(lds + PTAB_OFF);
    if (threadIdx.x == 0) {
#pragma unroll
        for (int i = 0; i < 34; ++i) ptab[i] = (unsigned long long)a.in[i];
        ptab[34] = (unsigned long long)a.out; ptab[35] = (unsigned long long)a.ws;
        ((volatile LAS unsigned*)(lds + PTAB_OFF + 512))[0] = 0u; ((volatile LAS unsigned*)(lds + PTAB_OFF + 512))[1] = 0u;
    }
    __syncthreads();
    { const XcdBarrier xb0 = xcd_barrier_post((unsigned*)a.ws, (volatile LAS unsigned*)(lds + PTAB_OFF + 512)); if (threadIdx.x == 0) ((volatile LAS unsigned*)(lds + PTAB_OFF + 512))[2] = xb0.x; }
    __syncthreads();
    const int ph_lo = a.ph_lo, ph_hi = a.ph_hi;
#define INP(i) ((const float*)ldptr(ptab, (i)))

    for (int ph = ph_lo; ph < ph_hi; ++ph) {
        unsigned char* ws = (unsigned char*)ldptr(ptab, 35);
        float* const outp = (float*)ldptr(ptab, 34);
        const int* pos = (const int*)INP(1);
        int tid = threadIdx.x; asm volatile("" : "+v"(tid));
        const int wid = tid >> 6, lane = tid & 63;
        const long gtid = (long)bid * 512 + tid, gth = (long)nb * 512;
        float* ssq = (float*)(ws + WS_SSQP);
        float* sqq = (float*)(ws + WS_SQQ); float* sqkv = (float*)(ws + WS_SQKV);
#define SSQI(i) (ssq + (size_t)((i) & 1) * MTOK * 16)
        bf16_t* XB = (bf16_t*)(ws + WS_XB); bf16_t* U = (bf16_t*)(ws + WS_U);
        if (PHON(0) && ph == 0) {
          for (int rep = 0; rep < NREP(0); ++rep) {
            for (int row = bid * 8 + wid; row < MTOK; row += nb * 8) {
                const float* xr = INP(0) + (size_t)row * DM; float sq = 0.f;
#pragma unroll
                for (int i = 0; i < 2; ++i) {
                    const int c = i * 512 + lane * 8;
                    const f32x4 x0 = *(const f32x4*)(xr + c), x1 = *(const f32x4*)(xr + c + 4);
                    float v[8] = {x0[0], x0[1], x0[2], x0[3], x1[0], x1[1], x1[2], x1[3]};
#pragma unroll
                    for (int j = 0; j < 8; ++j) sq += v[j] * v[j];
                    *(u32x4*)(XB + (size_t)row * DM + c) = pk8(v);
                }
                sq = wavesum(sq);
                if (lane == 0) { float* sp = ssq + (size_t)row * 16; *(f32x4*)sp = (f32x4){sq, 0.f, 0.f, 0.f}; *(f32x4*)(sp + 4) = (f32x4){0.f, 0.f, 0.f, 0.f}; *(f32x4*)(sp + 8) = (f32x4){0.f, 0.f, 0.f, 0.f}; *(f32x4*)(sp + 12) = (f32x4){0.f, 0.f, 0.f, 0.f}; }
            }
            convert_region_a(ptab, 0, gtid, gth);
            if (nb < 256) convert_region_b(ptab, 0, gtid, gth);
          }
        } else if (PHON(1) && ph == 19) {
            const float* fg = INP(33);
            for (int row = bid * 8 + wid; row < MTOK; row += nb * 8) {
                float* xr = outp + (size_t)row * DM;
                f32x4 xv[4]; float sq = 0.f;
#pragma unroll
                for (int i = 0; i < 4; ++i) { xv[i] = *(const f32x4*)(xr + i * 256 + lane * 4); sq += xv[i][0] * xv[i][0] + xv[i][1] * xv[i][1] + xv[i][2] * xv[i][2] + xv[i][3] * xv[i][3]; }
                sq = wavesum(sq);
                const float rs = rsqrtf(sq * (1.0f / DM) + NEPS);
#pragma unroll
                for (int i = 0; i < 4; ++i) { const int c = i * 256 + lane * 4; const f32x4 g = *(const f32x4*)(fg + c); *(f32x4*)(xr + c) = xv[i] * rs * g; }
            }
        } else {
            const int l = (ph - 1) / 9, k = (ph - 1) % 9;
            pg8::StaticOrder S;
            if (PHON(2) && (k == 0 || k == 7)) {
                const int f2 = (k == 7);
                pg8::Gemm g{XB, (const bf16_t*)(ws + (f2 ? WS_WGU2 : WS_WGU1)), MTOK, 2 * FF, DM, DM, 512};
                pg8::EpiGU E{SSQI(3 * l + (f2 ? 2 : 0)), U};
                S.init(MTOK, 2 * FF, nb, bid);
                for (int rep = 0; rep < NREP(1); ++rep) pg8::gemm_phase(lds, g, S, E, tid);
            } else if (PHON(3) && (k == 1 || k == 8 || k == 6)) {
                pg8::Gemm g; pg8::EpiRes E;
                if (k == 6) { g = pg8::Gemm{U + U_CB, (const bf16_t*)(ws + WS_WOUT), MTOK, DM, DM, NU, 768 * 2}; E = pg8::EpiRes{outp, outp, XB, SSQI(3 * l + 2), 1.0f, 0}; }
                else { const int f2 = (k == 8);
                    g = pg8::Gemm{U, (const bf16_t*)(ws + (f2 ? WS_WD2 : WS_WD1)), MTOK, DM, FF, FF, 512};
                    E = pg8::EpiRes{(l == 0 && !f2) ? INP(0) : outp, outp, XB, SSQI(3 * l + (f2 ? 3 : 1)), 0.5f, 0}; }
                S.init(MTOK, DM, nb, bid);
                { const int nr = (k == 6) ? NREP(9) : NREP(8); for (int rep = 0; rep < nr; ++rep) { E.dry = (rep + 1 < nr) ? 1 : ((k == 8 && l == 1) ? -1 : 0); pg8::gemm_phase(lds, g, S, E, tid); } }
            } else if (PHON(4) && k == 2) {
                pg8::Gemm g{XB, (const bf16_t*)(ws + WS_WIN), MTOK, NU, DM, DM, 512};
                pg8::EpiWin E{SSQI(3 * l + 1), pos, U, sqq, sqkv, (bf16_t*)(ws + WS_KR), (bf16_t*)(ws + WS_VTR)};
                S.init(MTOK, NU, nb, bid);
                for (int rep = 0; rep < NREP(2); ++rep) pg8::gemm_phase(lds, g, S, E, tid);
            } else if (PHON(5) && k == 3) {
                if (PHON(8)) {   pg8::Gemm g{U + U_LORA, (const bf16_t*)(ws + WS_WLORA), MTOK, 1280, 384, NU, 512};
                    pg8::EpiLora E{ws, INP(10) + l * 256, INP(11) + l * 256, INP(14) + l * 256, INP(15) + l * 256};
                    S.init(MTOK, 1280, nb, bid);
                    for (int rep = 0; rep < NREP(3); ++rep) pg8::gemm_phase(lds, g, S, E, tid); }
                if (PHON(9)) {   pg8::Gemm g{U + U_QA, (const bf16_t*)(ws + WS_WMLA), MTOK, 1024, 512, NU, 512};
                    pg8::EpiMla E{sqq, sqkv, pos, (bf16_t*)(ws + WS_QM), (bf16_t*)(ws + WS_KN), (bf16_t*)(ws + WS_VTM)};
                    S.init(MTOK, 1024, nb, bid);
                    for (int rep = 0; rep < NREP(3); ++rep) pg8::gemm_phase(lds, g, S, E, tid); }
                if (PHON(10)) {
                    const float* cw = INP(9) + l * 768;
                    for (int rep = 0; rep < NREP(6); ++rep)
                    for (long it = gtid; it < (long)MTOK * 32; it += gth) {
                        const int tok = (int)(it >> 5), c8 = (int)(it & 31) * 8, t = tok & (SEQ - 1);
                        float acc8[8] = {0.f, 0.f, 0.f, 0.f, 0.f, 0.f, 0.f, 0.f};
#pragma unroll
                        for (int j = 0; j < 3; ++j) {
                            const int tt = t + j - 1;
                            if (tt >= 0 && tt < SEQ) {
                                const bf16_t* ur = U + (size_t)(tok + j - 1) * NU;
                                float cx[8], cc[8]; unpk8(*(const u32x4*)(ur + U_CX + c8), cx); unpk8(*(const u32x4*)(ur + U_CC + c8), cc);
#pragma unroll
                                for (int i = 0; i < 8; ++i) acc8[i] += cw[j * 256 + c8 + i] * (cx[i] * cc[i]);
                            }
                        }
                        bf16_t* bp = U + (size_t)tok * NU + U_CB + c8; float cb[8]; unpk8(*(const u32x4*)bp, cb);
#pragma unroll
                        for (int i = 0; i < 8; ++i) acc8[i] *= cb[i];
                        *(u32x4*)(rep + 1 < NREP(6) ? U + (size_t)tok * NU + U_TV + c8 : bp) = pk8(acc8);
                    }
                }
            } else if (PHON(6) && k == 4) {
                for (int rep = 0; rep < NREP(4); ++rep) for (int sx = bid; sx < 128; sx += nb) rwkv_scan(lds, ws, INP(19) + l * 256, INP(20) + l * 256, sx, tid);
                for (int rep = 0; rep < NREP(5); ++rep) {
                    unsigned* ctr = (unsigned*)ws + 3600 + l + 2 * rep;
                    volatile LAS unsigned* uw = (volatile LAS unsigned*)(lds + PTAB_OFF + 640);
                    const float* gng = INP(24) + l * 256;
                    const int ocol = (rep + 1 < NREP(5)) ? U_TV : U_TG;
                    for (;;) {
                        __syncthreads();
                        if (tid == 0) *uw = atomicAdd(ctr, 1u);
                        __syncthreads();
                        const int unit = __builtin_amdgcn_readfirstlane(*uw);
                        if (unit >= 512) break;
                        if (unit < 256) attn_unit<0>(lds, ws, nullptr, unit, tid); else attn_unit<1>(lds, ws, gng, unit - 256, tid, ocol);
                    }
                }
                if (nb >= 256 && bid >= 128) {
                    const long g2 = (long)(bid - 128) * 512 + tid, gt2 = (long)128 * 512;
                    if (l == 0) { convert_region_b(ptab, 0, g2, gt2); convert_region_a(ptab, 1, g2, gt2); } else convert_region_b(ptab, 1, g2, gt2);
                } else if (nb < 256) { if (l == 0) convert_region_a(ptab, 1, gtid, gth); else convert_region_b(ptab, 1, gtid, gth); }
            } else if (PHON(7) && k == 5) {
                const bf16_t* YF = (const bf16_t*)(ws + WS_YF); const bf16_t* YB = (const bf16_t*)(ws + WS_YB);
                const bf16_t* AF = (const bf16_t*)(ws + WS_AF); const bf16_t* AB = (const bf16_t*)(ws + WS_AB); const bf16_t* GG = (const bf16_t*)(ws + WS_GG);
                const float* k_a = INP(20) + l * 256; const float* r_k = INP(21) + l * 256; const float* lg = INP(22) + l * 256; const float* lb = INP(23) + l * 256;
                for (int rep = 0; rep < NREP(7); ++rep)
                for (int gidx = bid * 32 + (tid >> 4); gidx < MTOK * 4; gidx += nb * 32) {
                    const int tok = gidx >> 2, h = gidx & 3, ch = h * 64 + 4 * (tid & 15);
                    const size_t lr = (size_t)tok * 256 + ch; bf16_t* ur = U + (size_t)tok * NU;
                    const u32x2 wf = *(const u32x2*)(YF + lr), wb = *(const u32x2*)(YB + lr);
                    f32x4 y = {bflo(wf.x) + bflo(wb.x), bfhi(wf.x) + bfhi(wb.x), bflo(wf.y) + bflo(wb.y), bfhi(wf.y) + bfhi(wb.y)};
                    const float mu = rowsum16(y[0] + y[1] + y[2] + y[3]) * (1.0f / 64.0f);
                    const f32x4 d = y - mu;
                    const float var = rowsum16(d[0] * d[0] + d[1] * d[1] + d[2] * d[2] + d[3] * d[3]) * (1.0f / 64.0f);
                    const float rsd = rsqrtf(var + 64e-5f);
                    const u32x2 wr_ = *(const u32x2*)(ur + U_RR + ch), wk_ = *(const u32x2*)(ur + U_RK + ch), wv_ = *(const u32x2*)(ur + U_RV + ch);
                    const u32x2 waf = *(const u32x2*)(AF + lr), wab = *(const u32x2*)(AB + lr), wg_ = *(const u32x2*)(GG + lr);
                    const f32x4 r4 = {bflo(wr_.x), bfhi(wr_.x), bflo(wr_.y), bfhi(wr_.y)}, k4 = {bflo(wk_.x), bfhi(wk_.x), bflo(wk_.y), bfhi(wk_.y)}, v4 = {bflo(wv_.x), bfhi(wv_.x), bflo(wv_.y), bfhi(wv_.y)};
                    const f32x4 af = {bflo(waf.x), bfhi(waf.x), bflo(waf.y), bfhi(waf.y)}, ab = {bflo(wab.x), bfhi(wab.x), bflo(wab.y), bfhi(wab.y)}, g4 = {bflo(wg_.x), bfhi(wg_.x), bflo(wg_.y), bfhi(wg_.y)};
                    const f32x4 ka = *(const f32x4*)(k_a + ch), rk = *(const f32x4*)(r_k + ch), lg4 = *(const f32x4*)(lg + ch), lb4 = *(const f32x4*)(lb + ch);
                    const f32x4 ksum = k4 * (2.0f + (af + ab - 2.0f) * ka);
                    const f32x4 pr = r4 * ksum * rk;
                    const float bs = rowsum16(pr[0] + pr[1] + pr[2] + pr[3]);
                    const f32x4 o = (d * rsd * lg4 + lb4 + bs * v4) * g4;
                    u32x2 w; w.x = pk2(o[0], o[1]); w.y = pk2(o[2], o[3]);
                    *(u32x2*)(ur + (rep + 1 < NREP(7) ? U_TV : U_RR) + ch) = w;
                }

            }
        }
        if (ph + 1 < ph_hi) {
            if (ph_hi > 1000) grid.sync();
            { XcdBarrier xb; xb.st = (volatile LAS unsigned*)(lds + PTAB_OFF + 512); xb.bar = (unsigned*)ldptr(ptab, 35); xb.x = __builtin_amdgcn_readfirstlane(xb.st[2]); xcd_barrier(xb); if (NREP(10) > 1) { xcd_barrier(xb); xcd_barrier(xb); } }
        }
    }
}

#ifndef RUNMASK
#define RUNMASK 0xFFFFF
#endif
#ifndef MK_MULTI
#define MK_MULTI 0
#endif
extern "C" void kernel_launch(void* const* d_in, const int* in_sizes, int n_in, void* d_out, int out_size, void* d_ws, size_t ws_size, hipStream_t stream) {
    static int grid = 0;
    if (grid == 0) {
        if (n_in != 34 || ws_size < WS_END) { fprintf(stderr, "kernel_launch: unexpected n_in %d / ws %zu\n", n_in, ws_size); grid = -1; return; }
        if (hipFuncSetAttribute((const void*)fwd_kernel, hipFuncAttributeMaxDynamicSharedMemorySize, LDS_BYTES) != hipSuccess) { fprintf(stderr, "hipFuncSetAttribute failed\n"); grid = -1; return; }
        int dev = 0, cus = 0, per_cu = 0;
        hipGetDevice(&dev); hipDeviceGetAttribute(&cus, hipDeviceAttributeMultiprocessorCount, dev);
        hipOccupancyMaxActiveBlocksPerMultiprocessor(&per_cu, (const void*)fwd_kernel, 512, LDS_BYTES);
        (void)hipGetLastError();
        if (per_cu < 1) fprintf(stderr, "occupancy query says %d blocks per CU\n", per_cu);
        grid = cus > 0 ? cus : 256;
    }
    if (grid < 0) return;
    Args a{};
    for (int i = 0; i < 34; ++i) a.in[i] = (const float*)d_in[i];
    a.out = (float*)d_out; a.ws = (unsigned char*)d_ws;
    if (hipMemsetAsync(d_ws, 0, 16384, stream) != hipSuccess) { fprintf(stderr, "memset failed\n"); return; }
#if MK_MULTI
    for (int p = 0; p < 20; ++p) { if (!((RUNMASK >> p) & 1)) continue; a.ph_lo = p; a.ph_hi = p + 1; hipLaunchKernelGGL(fwd_kernel, dim3(grid), dim3(512), LDS_BYTES, stream, a); }
#else
    a.ph_lo = 0; a.ph_hi = 20;
    void* args[] = {&a};
    hipError_t e = hipLaunchCooperativeKernel((const void*)fwd_kernel, dim3(grid), dim3(512), args, LDS_BYTES, stream);
    if (e != hipSuccess) fprintf(stderr, "cooperative launch failed: %s (grid %d)\n", hipGetErrorString(e), grid);
#endif
}
```
